# Optimizing an MI355X kernel written in HIP

```python
import jax, jax.numpy as jnp
from jax import lax
import numpy as np

D_MODEL = 1024
BATCH = 32
SEQ = 2048
DEPTH = 1
DEC_BATCH = 4
DEC_SEQ = 8192
PAST_LEN = 128

MLA_HEADS = 8
Q_LORA = 256
KV_LORA = 128
NOPE_DIM = 64
ROPE_DIM = 32
MLA_V_DIM = 64
Q_BLOCK = 128
RET_HEADS = 8
RET_QK_DIM = 64
RET_V_DIM = 128
CHUNK = 128
D_FF = 4 * D_MODEL
ROPE_THETA = 10000.0
EPS = 1e-6

SPLITS = (Q_LORA, KV_LORA, ROPE_DIM,
          RET_HEADS * RET_QK_DIM, RET_HEADS * RET_QK_DIM,
          RET_HEADS * RET_V_DIM, RET_HEADS * RET_V_DIM,
          D_MODEL, D_MODEL)
D_IN = sum(SPLITS)

kernel_name = "hybrid_mla_retention_encoder"


def rms_norm(x, g=None):
    xf = x.astype(jnp.float32)
    y = xf * lax.rsqrt(jnp.mean(xf * xf, axis=-1, keepdims=True) + EPS)
    if g is not None:
        y = y * g.astype(jnp.float32)
    return y.astype(x.dtype)


def rope_tables(seq, dim):
    inv = 1.0 / (ROPE_THETA ** (jnp.arange(0, dim, 2, dtype=jnp.float32) / dim))
    ang = jnp.arange(seq, dtype=jnp.float32)[:, None] * inv[None, :]
    return jnp.cos(ang), jnp.sin(ang)


def apply_rope(x, cos, sin):
    half = x.shape[-1] // 2
    x1 = x[..., :half].astype(jnp.float32)
    x2 = x[..., half:].astype(jnp.float32)
    return jnp.concatenate([x1 * cos - x2 * sin, x1 * sin + x2 * cos], axis=-1).astype(x.dtype)


def mla_attention(q_nope, q_rope, k_nope, k_rope, v):
    B, S, H, _ = q_nope.shape
    nb = S // Q_BLOCK
    scale = (NOPE_DIM + ROPE_DIM) ** -0.5

    def block(args):
        qn, qr = args
        s = (jnp.einsum('bqhd,bkhd->bhqk', qn, k_nope)
             + jnp.einsum('bqhd,bkd->bhqk', qr, k_rope))
        p = jax.nn.softmax(s.astype(jnp.float32) * scale, axis=-1).astype(v.dtype)
        return jnp.einsum('bhqk,bkhd->bqhd', p, v)

    qn_b = q_nope.reshape(B, nb, Q_BLOCK, H, NOPE_DIM).transpose(1, 0, 2, 3, 4)
    qr_b = q_rope.reshape(B, nb, Q_BLOCK, H, ROPE_DIM).transpose(1, 0, 2, 3, 4)
    out = lax.map(block, (qn_b, qr_b))
    return out.transpose(1, 0, 2, 3, 4).reshape(B, S, H * MLA_V_DIM)


def retention_dir(q, k, v, log_gamma, inclusive):
    B, H, S, Dk = q.shape
    Dv = v.shape[-1]
    n = S // CHUNK
    lg = log_gamma.astype(jnp.float32)
    idx = jnp.arange(CHUNK, dtype=jnp.float32)
    diff = idx[:, None] - idx[None, :]
    mask = (diff >= 0) if inclusive else (diff > 0)
    intra = jnp.where(mask[None], jnp.exp(lg[:, None, None] * jnp.maximum(diff, 0.0)[None]), 0.0)
    q_dec = jnp.exp(lg[:, None] * (idx[None, :] + 1.0))
    k_dec = jnp.exp(lg[:, None] * (CHUNK - 1.0 - idx[None, :]))
    chunk_dec = jnp.exp(lg * CHUNK)

    qc = q.reshape(B, H, n, CHUNK, Dk)
    kc = k.reshape(B, H, n, CHUNK, Dk)
    vc = v.reshape(B, H, n, CHUNK, Dv)

    s = jnp.einsum('bhnid,bhnjd->bhnij', qc, kc) * intra[:, None]
    o_intra = jnp.einsum('bhnij,bhnjv->bhniv', s, vc)

    kv = jnp.einsum('bhnjd,bhnjv->nbhdv', kc * k_dec[:, None, :, None], vc).astype(jnp.float32)

    def step(state, kv_n):
        return state * chunk_dec[None, :, None, None] + kv_n, state

    _, states = lax.scan(step, jnp.zeros((B, H, Dk, Dv), jnp.float32), kv)
    o_cross = jnp.einsum('bhnid,nbhdv->bhniv', qc * q_dec[:, None, :, None], states)
    return (o_intra + o_cross).reshape(B, H, S, Dv).astype(v.dtype)


def mixer(h, w_in, g_q_norm, w_q_up, g_kv_norm, w_kv_up, w_branch_a,
          ret_log_decay_fwd, ret_log_decay_bwd, w_branch_b, w_out):
    B, S, _ = h.shape
    offsets = np.cumsum(np.array(SPLITS))[:-1].tolist()
    c_q, c_kv, k_r, rq, rk, rv, rg, ga, gb = jnp.split(h @ w_in, offsets, axis=-1)

    cos_m, sin_m = rope_tables(S, ROPE_DIM)
    q = (rms_norm(c_q, g_q_norm) @ w_q_up).reshape(B, S, MLA_HEADS, NOPE_DIM + ROPE_DIM)
    q_nope, q_rope = q[..., :NOPE_DIM], q[..., NOPE_DIM:]
    q_rope = apply_rope(q_rope, cos_m[:, None, :], sin_m[:, None, :])
    kv = (rms_norm(c_kv, g_kv_norm) @ w_kv_up).reshape(B, S, MLA_HEADS, NOPE_DIM + MLA_V_DIM)
    k_nope, v_a = kv[..., :NOPE_DIM], kv[..., NOPE_DIM:]
    k_rope = apply_rope(k_r, cos_m, sin_m)
    a = mla_attention(q_nope, q_rope, k_nope, k_rope, v_a) @ w_branch_a

    cos_r, sin_r = rope_tables(S, RET_QK_DIM)
    rq = apply_rope(rq.reshape(B, S, RET_HEADS, RET_QK_DIM), cos_r[:, None, :], sin_r[:, None, :])
    rk = apply_rope(rk.reshape(B, S, RET_HEADS, RET_QK_DIM), cos_r[:, None, :], sin_r[:, None, :])
    rq = rq.transpose(0, 2, 1, 3)
    rk = (rk * (RET_QK_DIM ** -0.5)).transpose(0, 2, 1, 3)
    rv = rv.reshape(B, S, RET_HEADS, RET_V_DIM).transpose(0, 2, 1, 3)
    o_f = retention_dir(rq, rk, rv, ret_log_decay_fwd, True)
    o_b = jnp.flip(retention_dir(jnp.flip(rq, 2), jnp.flip(rk, 2), jnp.flip(rv, 2),
                                 ret_log_decay_bwd, False), 2)
    o = rms_norm((o_f + o_b).transpose(0, 2, 1, 3))
    o = o.reshape(B, S, RET_HEADS * RET_V_DIM) * jax.nn.silu(rg)
    b = o @ w_branch_b

    merged = jax.nn.sigmoid(ga) * a + jax.nn.sigmoid(gb) * b
    return merged @ w_out


def trunk(x, g_pre_mix, w_in, g_q_norm, w_q_up, g_kv_norm, w_kv_up, w_branch_a,
          ret_log_decay_fwd, ret_log_decay_bwd, w_branch_b, w_out, g_post_mix,
          g_pre_mlp, w_up, w_down, g_post_mlp):
    for l in range(DEPTH):
        h = rms_norm(x, g_pre_mix[l])
        m = mixer(h, w_in[l], g_q_norm[l], w_q_up[l], g_kv_norm[l], w_kv_up[l], w_branch_a[l],
                  ret_log_decay_fwd[l], ret_log_decay_bwd[l], w_branch_b[l], w_out[l])
        x = x + rms_norm(m, g_post_mix[l])
        h = rms_norm(x, g_pre_mlp[l])
        u = jnp.square(jax.nn.relu(h @ w_up[l]))
        x = x + rms_norm(u @ w_down[l], g_post_mlp[l])
    return x


def setup_inputs(seed: int = 0) -> dict:
    key = jax.random.key(seed)
    ks = jax.random.split(key, 24)

    def w(k, fan_in, fan_out):
        return jax.random.normal(k, (DEPTH, fan_in, fan_out), jnp.float32) * fan_in ** -0.5

    def gain(k, dim):
        return 1.0 + 0.05 * jax.random.normal(k, (DEPTH, dim), jnp.float32)

    base = jnp.log1p(-jnp.exp2(-5.0 - jnp.arange(RET_HEADS, dtype=jnp.float32)))
    dec_f = base[None] * (1.0 + 0.05 * jax.random.normal(ks[20], (DEPTH, RET_HEADS), jnp.float32))
    dec_b = base[None] * (1.0 + 0.05 * jax.random.normal(ks[21], (DEPTH, RET_HEADS), jnp.float32))
    return {
        "x_prompt": jax.random.normal(ks[0], (BATCH, SEQ, D_MODEL), jnp.float32),
        "x_sample": jax.random.normal(ks[1], (DEC_BATCH, DEC_SEQ, D_MODEL), jnp.float32),
        "g_pre_mix": gain(ks[2], D_MODEL),
        "w_in": w(ks[3], D_MODEL, D_IN),
        "g_q_norm": gain(ks[4], Q_LORA),
        "w_q_up": w(ks[5], Q_LORA, MLA_HEADS * (NOPE_DIM + ROPE_DIM)),
        "g_kv_norm": gain(ks[6], KV_LORA),
        "w_kv_up": w(ks[7], KV_LORA, MLA_HEADS * (NOPE_DIM + MLA_V_DIM)),
        "w_branch_a": w(ks[8], MLA_HEADS * MLA_V_DIM, D_MODEL),
        "ret_log_decay_fwd": dec_f,
        "ret_log_decay_bwd": dec_b,
        "w_branch_b": w(ks[9], RET_HEADS * RET_V_DIM, D_MODEL),
        "w_out": w(ks[10], D_MODEL, D_MODEL),
        "g_post_mix": gain(ks[11], D_MODEL),
        "g_pre_mlp": gain(ks[12], D_MODEL),
        "w_up": w(ks[13], D_MODEL, D_FF),
        "w_down": w(ks[14], D_FF, D_MODEL),
        "g_post_mlp": gain(ks[15], D_MODEL),
    }


def reference(x_prompt, x_sample, g_pre_mix, w_in, g_q_norm, w_q_up, g_kv_norm, w_kv_up,
              w_branch_a, ret_log_decay_fwd, ret_log_decay_bwd, w_branch_b, w_out, g_post_mix,
              g_pre_mlp, w_up, w_down, g_post_mlp):
    y_prompt = trunk(x_prompt, g_pre_mix, w_in, g_q_norm, w_q_up, g_kv_norm, w_kv_up, w_branch_a,
                     ret_log_decay_fwd, ret_log_decay_bwd, w_branch_b, w_out, g_post_mix,
                     g_pre_mlp, w_up, w_down, g_post_mlp)
    y_sample = trunk(x_sample, g_pre_mix, w_in, g_q_norm, w_q_up, g_kv_norm, w_kv_up, w_branch_a,
                     ret_log_decay_fwd, ret_log_decay_bwd, w_branch_b, w_out, g_post_mix,
                     g_pre_mlp, w_up, w_down, g_post_mlp)
    return (y_prompt, y_sample)
```

```cpp
#include <hip/hip_runtime.h>
#include <hip/hip_cooperative_groups.h>
#include <cstdio>
#include <cstdint>
namespace cg = cooperative_groups;

#define LAS __attribute__((address_space(3)))
typedef unsigned short bf16_t;
typedef short bf16x8 __attribute__((ext_vector_type(8)));
typedef float f32x4 __attribute__((ext_vector_type(4)));
typedef float f32x16 __attribute__((ext_vector_type(16)));
typedef unsigned u32x4 __attribute__((ext_vector_type(4)));
typedef unsigned u32x2 __attribute__((ext_vector_type(2)));

namespace pg8 {
constexpr int BM = 256, BK = 64, HALF = 128, HTB = HALF * BK * 2, STAGE_BYTES = 8 * HTB, NXCD = 8, WGM = 8;
__host__ __device__ __forceinline__ int lds_byte(int r, int c) { const int st = (r >> 4) * 2 + (c >> 5), rr = r & 15, cc = c & 31, ob = rr * 64 + cc * 2; return st * 1024 + (ob ^ (((ob >> 9) & 1) << 5)); }
__host__ __device__ __forceinline__ void stage_rc(int b, int& R, int& C) { const int st = b / 1024, sb = b % 1024, swz = sb ^ (((sb >> 9) & 1) << 5); R = (st >> 1) * 16 + swz / 64; C = (st & 1) * 32 + (swz % 64) / 2; }
__host__ __device__ __forceinline__ int perm32(int rho) { const int n = rho >> 4, i = rho & 15; return 8 * (i >> 2) + 4 * n + (i & 3); }

struct Unit { int pm, pn; };
struct Gemm { const bf16_t* A; const bf16_t* Bt; int M, N, K; };

struct StaticOrder {
    int nM, nN, nwg, G, c;
    __host__ __device__ void init(int M, int N, int G_, int c_) { nM = M / BM; nN = N / BM; nwg = nM * nN; G = G_; c = c_; }
    __host__ __device__ bool next(int i, Unit& u) const {
        const long L = (long)i * G + c; if (L >= nwg) return false;
        int wgid = (int)L; { const int q = nwg / NXCD, r = nwg % NXCD, xcd = wgid % NXCD, off = wgid / NXCD; wgid = (xcd < r ? xcd * (q + 1) : r * (q + 1) + (xcd - r) * q) + off; }
        const int nig = WGM * nN, gid = wgid / nig, fm = gid * WGM, gsz = (nM - fm) < WGM ? (nM - fm) : WGM;
        u.pm = fm + ((wgid % nig) % gsz); u.pn = (wgid % nig) / gsz; return true;
    }
    __device__ __forceinline__ void a_ready(const Unit&) const {}
    __device__ __forceinline__ void done(const Unit&) const {}
};

__device__ __forceinline__ unsigned cvt_pk_bf16(float lo, float hi) { unsigned r; asm volatile("v_cvt_pk_bf16_f32 %0, %1, %2" : "=v"(r) : "v"(lo), "v"(hi)); return r; }

template <class Epi, class Sched, bool ALIGN_EPI = false, bool SP2 = false>
__device__ __forceinline__ void gemm_phase(LAS unsigned char* lds, const Gemm g, const Sched& S, const Epi& E) {
    int tid_ = threadIdx.x; asm volatile("" : "+v"(tid_));
    const int tid = tid_, wid = __builtin_amdgcn_readfirstlane(tid >> 6), lane = tid & 63, wr = wid >> 2, wc = wid & 3, fr = lane & 15, fq = lane >> 4;
    int K_ = g.K; asm volatile("" : "+s"(K_));
    const int K = K_, nt = K / BK;
    unsigned voffA[2], voffB[2];
#pragma unroll
    for (int i = 0; i < 2; ++i) { int R, C; stage_rc(tid * 16 + i * 8192, R, C); const int Rb = Epi::PERM ? ((R & ~31) + perm32(R & 31)) : R;
        voffA[i] = (unsigned)(R * K + C) * 2u; voffB[i] = (unsigned)(Rb * K + C) * 2u; }
    const size_t kstep = (size_t)(BK * 2);
    const size_t hstep = (size_t)HALF * K * 2;
    const size_t tstep = 2 * hstep;
    const unsigned ldsw = (unsigned)wid * 1024u;
    const int aoff = lds_byte(wr * 64 + fr, fq * 8), boff = lds_byte(wc * 32 + fr, fq * 8);
#define PG8_SA(b, h) (((b) * 2 + (h)) * HTB)
#define PG8_SB(b, h) ((4 + (b) * 2 + (h)) * HTB)
#define PG8_STAGE(bufoff, gbase, voff) do { _Pragma("unroll") for (int _i = 0; _i < 2; ++_i) \
        __builtin_amdgcn_global_load_lds((const unsigned*)((const char*)(gbase) + (voff)[_i]), (LAS unsigned*)(lds + (bufoff) + ldsw + _i * 8192), 16, 0, 0); } while (0)
#define PG8_LDA(dst, b, h) do { _Pragma("unroll") for (int m = 0; m < 4; ++m) _Pragma("unroll") for (int k = 0; k < 2; ++k) dst[m][k] = *(const LAS bf16x8*)(lds + PG8_SA(b, h) + aoff + m * 2048 + k * 1024); } while (0)
#define PG8_LDB(dst, b, h) do { _Pragma("unroll") for (int n = 0; n < 2; ++n) _Pragma("unroll") for (int k = 0; k < 2; ++k) dst[n][k] = *(const LAS bf16x8*)(lds + PG8_SB(b, h) + boff + n * 2048 + k * 1024); } while (0)
#define PG8_MMA(ai, bj, At, Bt) do { __builtin_amdgcn_s_setprio(1); _Pragma("unroll") for (int m = 0; m < 4; ++m) _Pragma("unroll") for (int n = 0; n < 2; ++n) _Pragma("unroll") for (int k = 0; k < 2; ++k) \
        acc[ai][bj][m][n] = __builtin_amdgcn_mfma_f32_16x16x32_bf16(Bt[n][k], At[m][k], acc[ai][bj][m][n], 0, 0, 0); __builtin_amdgcn_s_setprio(0); } while (0)
#define PG8_WAIT_V(n) asm volatile("s_waitcnt vmcnt(" #n ")" ::: "memory")
#define PG8_WAIT_L(n) asm volatile("s_waitcnt lgkmcnt(" #n ")" ::: "memory")
#define PG8_BAR __builtin_amdgcn_s_barrier()
#define PG8_SCHED __builtin_amdgcn_sched_barrier(0)
    Unit cur, nxt; int ui = 0;
    if (!S.next(0, cur)) return;
    f32x4 acc[2][2][4][2];
#pragma unroll
    for (int a = 0; a < 2; ++a)
#pragma unroll
        for (int b = 0; b < 2; ++b)
#pragma unroll
            for (int m = 0; m < 4; ++m)
#pragma unroll
                for (int n = 0; n < 2; ++n) acc[a][b][m][n] = (f32x4){0.f, 0.f, 0.f, 0.f};
    bf16x8 At[4][2], B0[2][2], B1[2][2];
    const char* cA = (const char*)g.A + (size_t)cur.pm * tstep; const char* cB = (const char*)g.Bt + (size_t)cur.pn * tstep;
    S.a_ready(cur);
    if constexpr (SP2) {
        PG8_STAGE(PG8_SB(0, 0), cB, voffB); PG8_STAGE(PG8_SB(0, 1), cB + hstep, voffB); PG8_STAGE(PG8_SA(0, 0), cA, voffA); PG8_STAGE(PG8_SA(0, 1), cA + hstep, voffA);
        if (wr == 1) PG8_BAR;
        PG8_WAIT_V(2); PG8_BAR;
        PG8_STAGE(PG8_SB(1, 0), cB + kstep, voffB); PG8_STAGE(PG8_SA(1, 0), cA + kstep, voffA); PG8_STAGE(PG8_SB(1, 1), cB + hstep + kstep, voffB);
        PG8_WAIT_V(6); PG8_BAR;
    } else {
        PG8_STAGE(PG8_SB(0, 0), cB, voffB); PG8_STAGE(PG8_SA(0, 0), cA, voffA); PG8_STAGE(PG8_SB(0, 1), cB + hstep, voffB); PG8_STAGE(PG8_SA(0, 1), cA + hstep, voffA);
        if (wr == 1) PG8_BAR;
        PG8_WAIT_V(4); PG8_BAR;
        PG8_STAGE(PG8_SB(1, 0), cB + kstep, voffB); PG8_STAGE(PG8_SA(1, 0), cA + kstep, voffA); PG8_STAGE(PG8_SB(1, 1), cB + hstep + kstep, voffB);
        PG8_WAIT_V(6); PG8_BAR;
    }
    for (;;) {
        const bool has_next = S.next(ui + 1, nxt);
        const char* nA = has_next ? (const char*)g.A + (size_t)nxt.pm * tstep : cA; const char* nB = has_next ? (const char*)g.Bt + (size_t)nxt.pn * tstep : cB;
        for (int t = 0; t < nt; t += 2) {
            const bool last = (t == nt - 2);
            const char* a1 = cA + (size_t)(t + 1) * kstep;
            const char* a2 = last ? nA : cA + (size_t)(t + 2) * kstep; const char* b2 = last ? nB : cB + (size_t)(t + 2) * kstep;
            const char* a3 = a2 + kstep; const char* b3 = b2 + kstep;
            if (last && has_next) S.a_ready(nxt);
            if constexpr (SP2) {
            PG8_LDB(B0, 0, 0); PG8_LDB(B1, 0, 1); PG8_SCHED; PG8_LDA(At, 0, 0); PG8_STAGE(PG8_SA(1, 1), a1 + hstep, voffA);
            PG8_WAIT_V(8); PG8_WAIT_L(0); PG8_BAR; PG8_MMA(0, 0, At, B0); PG8_MMA(0, 1, At, B1); PG8_BAR; PG8_SCHED;
            PG8_LDA(At, 0, 1); PG8_STAGE(PG8_SB(0, 0), b2, voffB); PG8_STAGE(PG8_SB(0, 1), b2 + hstep, voffB); PG8_STAGE(PG8_SA(0, 0), a2, voffA);
            PG8_WAIT_V(8); PG8_WAIT_L(0); PG8_BAR; PG8_MMA(1, 0, At, B0); PG8_MMA(1, 1, At, B1); PG8_BAR; PG8_SCHED;
            PG8_LDB(B0, 1, 0); PG8_LDB(B1, 1, 1); PG8_SCHED; PG8_LDA(At, 1, 0); PG8_STAGE(PG8_SA(0, 1), a2 + hstep, voffA);
            PG8_WAIT_V(8); PG8_WAIT_L(0); PG8_BAR; PG8_MMA(0, 0, At, B0); PG8_MMA(0, 1, At, B1); PG8_BAR; PG8_SCHED;
            PG8_LDA(At, 1, 1); PG8_STAGE(PG8_SB(1, 0), b3, voffB); PG8_STAGE(PG8_SB(1, 1), b3 + hstep, voffB); PG8_STAGE(PG8_SA(1, 0), a3, voffA);
            PG8_WAIT_V(8); PG8_WAIT_L(0); PG8_BAR; PG8_MMA(1, 0, At, B0); PG8_MMA(1, 1, At, B1); PG8_BAR; PG8_SCHED;
            } else {
            PG8_LDB(B0, 0, 0); PG8_SCHED; PG8_LDA(At, 0, 0); PG8_STAGE(PG8_SA(1, 1), a1 + hstep, voffA);
            PG8_WAIT_L(8); PG8_BAR; PG8_WAIT_L(0); PG8_MMA(0, 0, At, B0); PG8_BAR; PG8_SCHED;
            PG8_LDB(B1, 0, 1); PG8_STAGE(PG8_SB(0, 0), b2, voffB);
            PG8_BAR; PG8_WAIT_L(0); PG8_MMA(0, 1, At, B1); PG8_BAR;
            PG8_LDA(At, 0, 1); PG8_STAGE(PG8_SA(0, 0), a2, voffA);
            PG8_BAR; PG8_WAIT_L(0); PG8_MMA(1, 0, At, B0); PG8_BAR; PG8_SCHED;
            PG8_STAGE(PG8_SB(0, 1), b2 + hstep, voffB);
            PG8_WAIT_V(6); PG8_BAR; PG8_MMA(1, 1, At, B1); PG8_BAR;
            PG8_LDB(B0, 1, 0); PG8_SCHED; PG8_LDA(At, 1, 0); PG8_STAGE(PG8_SA(0, 1), a2 + hstep, voffA);
            PG8_WAIT_L(8); PG8_BAR; PG8_WAIT_L(0); PG8_MMA(0, 0, At, B0); PG8_BAR; PG8_SCHED;
            PG8_LDB(B1, 1, 1); PG8_STAGE(PG8_SB(1, 0), b3, voffB);
            PG8_BAR; PG8_WAIT_L(0); PG8_MMA(0, 1, At, B1); PG8_BAR;
            PG8_LDA(At, 1, 1); PG8_STAGE(PG8_SA(1, 0), a3, voffA);
            PG8_BAR; PG8_WAIT_L(0); PG8_MMA(1, 0, At, B0); PG8_BAR; PG8_SCHED;
            PG8_STAGE(PG8_SB(1, 1), b3 + hstep, voffB);
            PG8_WAIT_V(6); PG8_BAR; PG8_MMA(1, 1, At, B1); PG8_BAR;
            }
        }
        if constexpr (ALIGN_EPI) { if (wr == 0) PG8_BAR; }
        E(acc, cur, wr, wc, fr, fq);
        if (!has_next) break;
#pragma unroll
        for (int a = 0; a < 2; ++a)
#pragma unroll
            for (int b = 0; b < 2; ++b)
#pragma unroll
                for (int m = 0; m < 4; ++m)
#pragma unroll
                    for (int n = 0; n < 2; ++n) acc[a][b][m][n] = (f32x4){0.f, 0.f, 0.f, 0.f};
        cur = nxt; cA = nA; cB = nB; ++ui;
        if constexpr (ALIGN_EPI) { if (wr == 1) PG8_BAR; }
    }
    PG8_WAIT_V(0);
    if constexpr (!ALIGN_EPI) { if (wr == 0) PG8_BAR; }
    PG8_BAR;
#undef PG8_SA
#undef PG8_SB
#undef PG8_STAGE
#undef PG8_LDA
#undef PG8_LDB
#undef PG8_MMA
#undef PG8_WAIT_V
#undef PG8_WAIT_L
#undef PG8_BAR
#undef PG8_SCHED
}
}

constexpr int DM = 1024, TG = 32768, NGROUPS = 3, DFF = 4096;
constexpr int N1A = 2560, N1B = 3072, NQ = 768, NKV = 1024;
constexpr float EPS = 1e-6f;
constexpr float LOG2E = 1.4426950408889634f;
constexpr float QSCALE = 0.10206207261596575f * LOG2E;
constexpr float LOG2_THETA = 13.287712379549449f;
constexpr float INV_2PI = 0.15915494309189535f;

constexpr size_t MiB = 1u << 20;
constexpr size_t WS_SSQ = 0;
constexpr size_t WS_BAR = 1792 * 1024;
constexpr size_t WS_W1A = 2 * MiB;
constexpr size_t WS_W1B = 7 * MiB;
constexpr size_t WS_WQ = 13 * MiB;
constexpr size_t WS_WKV = 13 * MiB + 512 * 1024;
constexpr size_t WS_WA = 14 * MiB;
constexpr size_t WS_WB = 15 * MiB;
constexpr size_t WS_WO = 17 * MiB;
constexpr size_t WS_WU = 19 * MiB;
constexpr size_t WS_WD = 27 * MiB;
constexpr size_t WS_ACT = 40 * MiB;
constexpr size_t A_HBF = WS_ACT + 0 * MiB, A_CQ = WS_ACT + 64 * MiB, A_CKV = WS_ACT + 80 * MiB, A_KR = WS_ACT + 88 * MiB;
constexpr size_t A_RQ = WS_ACT + 96 * MiB, A_RK = WS_ACT + 128 * MiB, A_RVT = WS_ACT + 160 * MiB, A_QN = WS_ACT + 224 * MiB;
constexpr size_t A_QR = WS_ACT + 256 * MiB, A_KN = WS_ACT + 272 * MiB, A_VT = WS_ACT + 304 * MiB, A_ST = WS_ACT + 336 * MiB;
constexpr size_t A_G3 = WS_ACT + 400 * MiB;
constexpr size_t A_OB = WS_ACT + 592 * MiB, A_MA = WS_ACT + 656 * MiB, A_MG = WS_ACT + 784 * MiB;
constexpr size_t A_MF = WS_ACT + 0 * MiB, A_H2 = WS_ACT + 128 * MiB, A_U = WS_ACT + 192 * MiB, A_DF = WS_ACT + 448 * MiB;
constexpr size_t A_X1 = WS_ACT + 512 * MiB;
constexpr size_t WS_NEED = WS_ACT + 848 * MiB;

constexpr int LDS_BYTES = 155648;
constexpr int LDS_TSCR = 131328, TS_P = 80;

__device__ __forceinline__ float bf_lo(unsigned u) { return __uint_as_float(u << 16); }
__device__ __forceinline__ float bf_hi(unsigned u) { return __uint_as_float(u & 0xffff0000u); }
__device__ __forceinline__ bf16_t f2bf(float f) { return (bf16_t)(pg8::cvt_pk_bf16(f, f) & 0xffffu); }
__device__ __forceinline__ float wave_sum(float v) {
#pragma unroll
    for (int o = 1; o < 64; o <<= 1) v += __shfl_xor(v, o);
    return v;
}
__device__ __forceinline__ float fast_exp2(float x) { return __builtin_amdgcn_exp2f(x); }
__device__ __forceinline__ float sigmoidf_(float v) { return __builtin_amdgcn_rcpf(1.0f + fast_exp2(-v * LOG2E)); }
__device__ __forceinline__ void sincos_rev(float pos, float invf, float& s, float& c) {
    const float ang = pos * invf; const float fr = __builtin_amdgcn_fractf(ang * INV_2PI);
    s = __builtin_amdgcn_sinf(fr); c = __builtin_amdgcn_cosf(fr);
}
__device__ __forceinline__ void atomic_addf(float* p, float v) { __hip_atomic_fetch_add(p, v, __ATOMIC_RELAXED, __HIP_MEMORY_SCOPE_AGENT); }
__device__ __forceinline__ u32x4 pack8(const f32x4& a, const f32x4& b) {
    u32x4 w; w.x = pg8::cvt_pk_bf16(a[0], a[1]); w.y = pg8::cvt_pk_bf16(a[2], a[3]); w.z = pg8::cvt_pk_bf16(b[0], b[1]); w.w = pg8::cvt_pk_bf16(b[2], b[3]); return w;
}

typedef f32x4 AccT[2][2][4][2];
template <class T> __device__ __forceinline__ T* at(const void* base, unsigned byteoff) { return (T*)((char*)base + byteoff); }

struct Epi1 {
    static constexpr bool PERM = true;
    bf16_t *CQ, *CKV, *KR, *RQ, *RK, *RVT; float *ssq_q, *ssq_kv; int slog; LAS unsigned char* tscr;
    __device__ __forceinline__ void operator()(const AccT& acc, const pg8::Unit& u, int wr, int wc, int fr, int fq) const {
        asm volatile("" : "+v"(fr), "+v"(fq), "+s"(wr), "+s"(wc));
        const int pn = u.pn, S = 1 << slog; const int rowb = u.pm * 256 + wr * 64 + fr;
        if (pn == 0) {
#pragma unroll
            for (int ai = 0; ai < 2; ++ai)
#pragma unroll
                for (int m = 0; m < 4; ++m) { const int row = rowb + ai * 128 + m * 16; float s = 0.f;
#pragma unroll
                    for (int bj = 0; bj < 2; ++bj) { const f32x4 v0 = acc[ai][bj][m][0], v1 = acc[ai][bj][m][1];
                        s += (v0[0] * v0[0] + v0[1] * v0[1]) + (v0[2] * v0[2] + v0[3] * v0[3]) + (v1[0] * v1[0] + v1[1] * v1[1]) + (v1[2] * v1[2] + v1[3] * v1[3]);
                        *at<u32x4>(CQ, 2u * (unsigned)(row * 256 + bj * 128 + wc * 32 + 8 * fq)) = pack8(v0, v1); }
                    s += __shfl_xor(s, 16); s += __shfl_xor(s, 32);
                    if (fq == 0) atomic_addf(at<float>(ssq_q, 4u * (unsigned)row), s); }
        } else if (pn == 1) {
            float invf[4];
#pragma unroll
            for (int j = 0; j < 4; ++j) invf[j] = fast_exp2(-(float)(4 * fq + j) * (LOG2_THETA / 16.0f));
#pragma unroll
            for (int ai = 0; ai < 2; ++ai)
#pragma unroll
                for (int m = 0; m < 4; ++m) { const int row = rowb + ai * 128 + m * 16;
                    { const f32x4 v0 = acc[ai][0][m][0], v1 = acc[ai][0][m][1];
                      float s = (v0[0] * v0[0] + v0[1] * v0[1]) + (v0[2] * v0[2] + v0[3] * v0[3]) + (v1[0] * v1[0] + v1[1] * v1[1]) + (v1[2] * v1[2] + v1[3] * v1[3]);
                      *at<u32x4>(CKV, 2u * (unsigned)(row * 128 + wc * 32 + 8 * fq)) = pack8(v0, v1);
                      s += __shfl_xor(s, 16); s += __shfl_xor(s, 32);
                      if (fq == 0) atomic_addf(at<float>(ssq_kv, 4u * (unsigned)row), s); }
                    if (wc == 0) { const f32x4 x1 = acc[ai][1][m][0], x2 = acc[ai][1][m][1]; const float pos = (float)(row & (S - 1)); f32x4 o1, o2;
#pragma unroll
                        for (int j = 0; j < 4; ++j) { float sn, cs; sincos_rev(pos, invf[j], sn, cs); o1[j] = x1[j] * cs - x2[j] * sn; o2[j] = x1[j] * sn + x2[j] * cs; }
                        *at<u32x4>(KR, 2u * (unsigned)(row * 32 + 8 * fq)) = pack8(o1, o2); } }
        } else if (pn <= 5) {
            const bool isk = pn >= 4; bf16_t* dst = isk ? RK : RQ; const float sc = isk ? 0.125f : 1.0f; const int colt = (pn & 1) * 256;
            const int g = (wc & 1) * 4 + fq; float invf[4];
#pragma unroll
            for (int j = 0; j < 4; ++j) invf[j] = fast_exp2(-(float)(4 * g + j) * (LOG2_THETA / 32.0f));
#pragma unroll
            for (int ai = 0; ai < 2; ++ai)
#pragma unroll
                for (int m = 0; m < 4; ++m) { const int row = rowb + ai * 128 + m * 16; const float pos = (float)(row & (S - 1)); float sn[4], cs[4];
#pragma unroll
                    for (int j = 0; j < 4; ++j) sincos_rev(pos, invf[j], sn[j], cs[j]);
#pragma unroll
                    for (int bj = 0; bj < 2; ++bj) { const f32x4 x1 = acc[ai][bj][m][0], x2 = acc[ai][bj][m][1]; f32x4 o1, o2;
#pragma unroll
                        for (int j = 0; j < 4; ++j) { o1[j] = (x1[j] * cs[j] - x2[j] * sn[j]) * sc; o2[j] = (x1[j] * sn[j] + x2[j] * cs[j]) * sc; }
                        *at<u32x4>(dst, 2u * (unsigned)(row * 512 + colt + bj * 128 + wc * 32 + 8 * fq)) = pack8(o1, o2); } }
        } else {
            LAS unsigned char* tl = tscr + (wr * 4 + wc) * (32 * TS_P); const int lane = fq * 16 + fr, rdv = lane >> 1, rh = lane & 1;
#pragma unroll
            for (int ai = 0; ai < 2; ++ai)
#pragma unroll
                for (int mp = 0; mp < 2; ++mp)
#pragma unroll
                    for (int bj = 0; bj < 2; ++bj) {
#pragma unroll
                        for (int mm = 0; mm < 2; ++mm) { const int p = 8 * (fr >> 2) + 4 * mm + (fr & 3);
#pragma unroll
                            for (int n = 0; n < 2; ++n)
#pragma unroll
                                for (int j = 0; j < 4; ++j) *(LAS bf16_t*)(tl + (8 * fq + 4 * n + j) * TS_P + 2 * p) = f2bf(acc[ai][bj][2 * mp + mm][n][j]); }
                        const u32x4 q0 = *(const LAS u32x4*)(tl + rdv * TS_P + 32 * rh), q1 = *(const LAS u32x4*)(tl + rdv * TS_P + 32 * rh + 16);
                        const int tokb = u.pm * 256 + ai * 128 + wr * 64 + 32 * mp; const int seq = tokb >> slog, posb = tokb & (S - 1);
                        const int colb = (pn - 6) * 256 + bj * 128 + wc * 32; const int head = colb >> 7, dvh = colb & 127;
                        const unsigned gb = 2u * (unsigned)(((seq * 8 + head) * 128 + dvh + rdv) * S + posb + 16 * rh);
                        *at<u32x4>(RVT, gb) = q0; *at<u32x4>(RVT, gb + 16u) = q1; }
        }
    }
};

struct Epi2q {
    static constexpr bool PERM = true;
    bf16_t *QN, *QR; const float* ssq_q; int slog;
    __device__ __forceinline__ void operator()(const AccT& acc, const pg8::Unit& u, int wr, int wc, int fr, int fq) const {
        asm volatile("" : "+v"(fr), "+v"(fq), "+s"(wr), "+s"(wc));
        const int pn = u.pn, S = 1 << slog; const int rowb = u.pm * 256 + wr * 64 + fr;
        float invf[4];
#pragma unroll
        for (int j = 0; j < 4; ++j) invf[j] = fast_exp2(-(float)(4 * fq + j) * (LOG2_THETA / 16.0f));
#pragma unroll
        for (int ai = 0; ai < 2; ++ai)
#pragma unroll
            for (int m = 0; m < 4; ++m) { const int row = rowb + ai * 128 + m * 16; const float f = rsqrtf(*at<const float>(ssq_q, 4u * (unsigned)row) * (1.0f / 256.0f) + EPS) * QSCALE;
                if (pn < 2) {
#pragma unroll
                    for (int bj = 0; bj < 2; ++bj) *at<u32x4>(QN, 2u * (unsigned)(row * 512 + pn * 256 + bj * 128 + wc * 32 + 8 * fq)) = pack8(acc[ai][bj][m][0] * f, acc[ai][bj][m][1] * f);
                } else { const float pos = (float)(row & (S - 1)); float sn[4], cs[4];
#pragma unroll
                    for (int j = 0; j < 4; ++j) sincos_rev(pos, invf[j], sn[j], cs[j]);
#pragma unroll
                    for (int bj = 0; bj < 2; ++bj) { const f32x4 x1 = acc[ai][bj][m][0], x2 = acc[ai][bj][m][1]; f32x4 o1, o2;
#pragma unroll
                        for (int j = 0; j < 4; ++j) { o1[j] = (x1[j] * cs[j] - x2[j] * sn[j]) * f; o2[j] = (x1[j] * sn[j] + x2[j] * cs[j]) * f; }
                        *at<u32x4>(QR, 2u * (unsigned)(row * 256 + bj * 128 + wc * 32 + 8 * fq)) = pack8(o1, o2); } } }
    }
};

struct Epi2kv {
    static constexpr bool PERM = true;
    bf16_t *KN, *VT; const float* ssq_kv; int slog; LAS unsigned char* tscr;
    __device__ __forceinline__ void operator()(const AccT& acc, const pg8::Unit& u, int wr, int wc, int fr, int fq) const {
        asm volatile("" : "+v"(fr), "+v"(fq), "+s"(wr), "+s"(wc));
        const int pn = u.pn, S = 1 << slog; const int rowb = u.pm * 256 + wr * 64 + fr;
        if (pn < 2) {
#pragma unroll
            for (int ai = 0; ai < 2; ++ai)
#pragma unroll
                for (int m = 0; m < 4; ++m) { const int row = rowb + ai * 128 + m * 16; const float f = rsqrtf(*at<const float>(ssq_kv, 4u * (unsigned)row) * (1.0f / 128.0f) + EPS);
#pragma unroll
                    for (int bj = 0; bj < 2; ++bj) *at<u32x4>(KN, 2u * (unsigned)(row * 512 + pn * 256 + bj * 128 + wc * 32 + 8 * fq)) = pack8(acc[ai][bj][m][0] * f, acc[ai][bj][m][1] * f); }
        } else {
            LAS unsigned char* tl = tscr + (wr * 4 + wc) * (32 * TS_P); const int lane = fq * 16 + fr, rdv = lane >> 1, rh = lane & 1;
            const int p16 = 8 * ((fr >> 2) & 1) + 4 * (fr >> 3) + (fr & 3);
#pragma unroll
            for (int ai = 0; ai < 2; ++ai)
#pragma unroll
                for (int mp = 0; mp < 2; ++mp) {
                    float f[2];
#pragma unroll
                    for (int mm = 0; mm < 2; ++mm) f[mm] = rsqrtf(*at<const float>(ssq_kv, 4u * (unsigned)(rowb + ai * 128 + (2 * mp + mm) * 16)) * (1.0f / 128.0f) + EPS);
#pragma unroll
                    for (int bj = 0; bj < 2; ++bj) {
#pragma unroll
                        for (int mm = 0; mm < 2; ++mm) { const int p = 16 * mm + p16;
#pragma unroll
                            for (int n = 0; n < 2; ++n)
#pragma unroll
                                for (int j = 0; j < 4; ++j) *(LAS bf16_t*)(tl + (8 * fq + 4 * n + j) * TS_P + 2 * p) = f2bf(acc[ai][bj][2 * mp + mm][n][j] * f[mm]); }
                        const u32x4 q0 = *(const LAS u32x4*)(tl + rdv * TS_P + 32 * rh), q1 = *(const LAS u32x4*)(tl + rdv * TS_P + 32 * rh + 16);
                        const int tokb = u.pm * 256 + ai * 128 + wr * 64 + 32 * mp; const int seq = tokb >> slog, posb = tokb & (S - 1);
                        const int colb = (pn - 2) * 256 + bj * 128 + wc * 32; const int head = colb >> 6, dvh = colb & 63;
                        const unsigned gb = 2u * (unsigned)(((seq * 8 + head) * 64 + dvh + rdv) * S + posb + 16 * rh);
                        *at<u32x4>(VT, gb) = q0; *at<u32x4>(VT, gb + 16u) = q1; } }
        }
    }
};

template <int ACT> struct EpiAct {
    static constexpr bool PERM = true;
    bf16_t* O; int ldc;
    __device__ __forceinline__ void operator()(const AccT& acc, const pg8::Unit& u, int wr, int wc, int fr, int fq) const {
        asm volatile("" : "+v"(fr), "+v"(fq), "+s"(wr), "+s"(wc));
        const int rowb = u.pm * 256 + wr * 64 + fr; int colt = u.pn * 256; unsigned boff = 0u; bool silu = false;
        if (ACT == 1) { const int t = u.pn >> 2; boff = (unsigned)t * (unsigned)(TG * 1024 * 2); colt = (u.pn & 3) * 256; silu = (t == 0); }
#pragma unroll
        for (int ai = 0; ai < 2; ++ai)
#pragma unroll
            for (int m = 0; m < 4; ++m) { const int row = rowb + ai * 128 + m * 16;
#pragma unroll
                for (int bj = 0; bj < 2; ++bj) { f32x4 v[2] = {acc[ai][bj][m][0], acc[ai][bj][m][1]};
#pragma unroll
                    for (int n = 0; n < 2; ++n)
#pragma unroll
                        for (int j = 0; j < 4; ++j) { const float x = v[n][j];
                            if (ACT == 1) { const float sg = sigmoidf_(x); v[n][j] = silu ? x * sg : sg; }
                            else { const float r = fmaxf(x, 0.f); v[n][j] = r * r; } }
                    *at<u32x4>(O, boff + 2u * (unsigned)(row * ldc + colt + bj * 128 + wc * 32 + 8 * fq)) = pack8(v[0], v[1]); } }
    }
};

struct Epi4 {
    static constexpr bool PERM = true;
    const bf16_t* SGA; bf16_t* MA;
    __device__ __forceinline__ void operator()(const AccT& acc, const pg8::Unit& u, int wr, int wc, int fr, int fq) const {
        asm volatile("" : "+v"(fr), "+v"(fq), "+s"(wr), "+s"(wc));
        const int rowb = u.pm * 256 + wr * 64 + fr;
#pragma unroll
        for (int ai = 0; ai < 2; ++ai)
#pragma unroll
            for (int m = 0; m < 4; ++m) { const int row = rowb + ai * 128 + m * 16;
#pragma unroll
                for (int bj = 0; bj < 2; ++bj) { const unsigned off = (unsigned)(row * 1024 + u.pn * 256 + bj * 128 + wc * 32 + 8 * fq);
                    const u32x4 gq = *at<const u32x4>(SGA, 2u * off); const f32x4 a0 = acc[ai][bj][m][0], a1 = acc[ai][bj][m][1];
                    f32x4 o0, o1; o0[0] = a0[0] * bf_lo(gq.x); o0[1] = a0[1] * bf_hi(gq.x); o0[2] = a0[2] * bf_lo(gq.y); o0[3] = a0[3] * bf_hi(gq.y);
                    o1[0] = a1[0] * bf_lo(gq.z); o1[1] = a1[1] * bf_hi(gq.z); o1[2] = a1[2] * bf_lo(gq.w); o1[3] = a1[3] * bf_hi(gq.w);
                    *at<u32x4>(MA, 2u * off) = pack8(o0, o1); } }
    }
};
struct Epi5 {
    static constexpr bool PERM = true;
    const bf16_t* SGB; const bf16_t* MA; bf16_t* MG;
    __device__ __forceinline__ void operator()(const AccT& acc, const pg8::Unit& u, int wr, int wc, int fr, int fq) const {
        asm volatile("" : "+v"(fr), "+v"(fq), "+s"(wr), "+s"(wc));
        const int rowb = u.pm * 256 + wr * 64 + fr;
#pragma unroll
        for (int ai = 0; ai < 2; ++ai)
#pragma unroll
            for (int m = 0; m < 4; ++m) { const int row = rowb + ai * 128 + m * 16;
#pragma unroll
                for (int bj = 0; bj < 2; ++bj) { const unsigned off = (unsigned)(row * 1024 + u.pn * 256 + bj * 128 + wc * 32 + 8 * fq);
                    const u32x4 gq = *at<const u32x4>(SGB, 2u * off); const f32x4 a0 = acc[ai][bj][m][0], a1 = acc[ai][bj][m][1];
                    const u32x4 mq = *at<const u32x4>(MA, 2u * off); f32x4 o0 = (f32x4){bf_lo(mq.x), bf_hi(mq.x), bf_lo(mq.y), bf_hi(mq.y)}, o1 = (f32x4){bf_lo(mq.z), bf_hi(mq.z), bf_lo(mq.w), bf_hi(mq.w)};
                    o0[0] += a0[0] * bf_lo(gq.x); o0[1] += a0[1] * bf_hi(gq.x); o0[2] += a0[2] * bf_lo(gq.y); o0[3] += a0[3] * bf_hi(gq.y);
                    o1[0] += a1[0] * bf_lo(gq.z); o1[1] += a1[1] * bf_hi(gq.z); o1[2] += a1[2] * bf_lo(gq.w); o1[3] += a1[3] * bf_hi(gq.w);
                    *at<u32x4>(MG, 2u * off) = pack8(o0, o1); } }
    }
};
struct EpiF32Ssq {
    static constexpr bool PERM = true;
    bf16_t* O; float* ssq;
    __device__ __forceinline__ void operator()(const AccT& acc, const pg8::Unit& u, int wr, int wc, int fr, int fq) const {
        asm volatile("" : "+v"(fr), "+v"(fq), "+s"(wr), "+s"(wc));
        const int rowb = u.pm * 256 + wr * 64 + fr;
#pragma unroll
        for (int ai = 0; ai < 2; ++ai)
#pragma unroll
            for (int m = 0; m < 4; ++m) { const int row = rowb + ai * 128 + m * 16; float s = 0.f;
#pragma unroll
                for (int bj = 0; bj < 2; ++bj) { const unsigned off = (unsigned)(row * 1024 + u.pn * 256 + bj * 128 + wc * 32 + 8 * fq); const f32x4 v0 = acc[ai][bj][m][0], v1 = acc[ai][bj][m][1];
                    s += (v0[0] * v0[0] + v0[1] * v0[1]) + (v0[2] * v0[2] + v0[3] * v0[3]) + (v1[0] * v1[0] + v1[1] * v1[1]) + (v1[2] * v1[2] + v1[3] * v1[3]);
                    *at<u32x4>(O, 2u * off) = pack8(v0, v1); }
                s += __shfl_xor(s, 16); s += __shfl_xor(s, 32);
                if (fq == 0) atomic_addf(at<float>(ssq, 4u * (unsigned)row), s); }
    }
};

struct Args {
    const float* x_prompt; const float* x_sample; const float* g_pre_mix; const float* w_in; const float* g_q_norm; const float* w_q_up;
    const float* g_kv_norm; const float* w_kv_up; const float* w_branch_a; const float* ldf; const float* ldb; const float* w_branch_b;
    const float* w_out; const float* g_post_mix; const float* g_pre_mlp; const float* w_up; const float* w_down; const float* g_post_mlp;
    float* out; unsigned char* ws;
};

__device__ __forceinline__ int src_col(int mode, int n, int coff) {
    if (mode == 0) return coff + n;
    if (mode == 1) {
        if (n < 256) return n;
        if (n < 384) return n;
        if (n < 416) { const int c = n - 384; return 384 + 16 * ((c >> 2) & 1) + 4 * (c >> 3) + (c & 3); }
        if (n < 512) return -1;
        if (n < 1536) { const int c = (n - 512) & 511, base = (n < 1024) ? 416 : 928; const int head = c >> 6, w = c & 63; return base + 64 * head + 32 * ((w >> 2) & 1) + 4 * (w >> 3) + (w & 3); }
        return 1440 + (n - 1536);
    }
    if (mode == 2) {
        if (n < 512) return 96 * (n >> 6) + (n & 63);
        const int c = n - 512, head = c >> 5, w = c & 31; return 96 * head + 64 + 16 * ((w >> 2) & 1) + 4 * (w >> 3) + (w & 3);
    }
    if (n < 512) return 128 * (n >> 6) + (n & 63);
    { const int c = n - 512; return 128 * (c >> 6) + 64 + (c & 63); }
}
struct CW { const float* W; int ldw, K, Nout, mode, coff; const float* gk; bf16_t* out; };
__device__ __forceinline__ void convert_item(const CW& c, int it) {
    const int n = it % c.Nout, kb = (it / c.Nout) * 64; const int sc = src_col(c.mode, n, c.coff);
#pragma unroll 2
    for (int sub = 0; sub < 8; ++sub) { const int k0 = kb + 8 * sub;
        float v[8];
#pragma unroll
        for (int e = 0; e < 8; ++e) { float x = (sc >= 0) ? c.W[(size_t)(k0 + e) * c.ldw + sc] : 0.f; if (c.gk) x *= c.gk[k0 + e]; v[e] = x; }
        u32x4 w; w.x = pg8::cvt_pk_bf16(v[0], v[1]); w.y = pg8::cvt_pk_bf16(v[2], v[3]); w.z = pg8::cvt_pk_bf16(v[4], v[5]); w.w = pg8::cvt_pk_bf16(v[6], v[7]);
        *(u32x4*)(c.out + (size_t)n * c.K + k0) = w; }
}

__device__ __forceinline__ float ssq4(const f32x4& v) { return (v[0] * v[0] + v[1] * v[1]) + (v[2] * v[2] + v[3] * v[3]); }
__device__ __forceinline__ u32x2 pk4(const f32x4& y) { u32x2 w; w.x = pg8::cvt_pk_bf16(y[0], y[1]); w.y = pg8::cvt_pk_bf16(y[2], y[3]); return w; }
__device__ __forceinline__ f32x4 unpk4(const u32x2& w) { return (f32x4){bf_lo(w.x), bf_hi(w.x), bf_lo(w.y), bf_hi(w.y)}; }
constexpr int RP_NR = 2;
__device__ __forceinline__ void rowpass0(const float* x, const float* g, bf16_t* HBF, int gw, int ngw, int lane) {
    f32x4 gv[4];
#pragma unroll
    for (int j = 0; j < 4; ++j) gv[j] = ((const f32x4*)g)[64 * j + lane];
    for (int r = gw; r < TG; r += RP_NR * ngw) {
        f32x4 v[RP_NR][4]; int rr[RP_NR];
#pragma unroll
        for (int k = 0; k < RP_NR; ++k) { rr[k] = (r + k * ngw < TG) ? r + k * ngw : r; const f32x4* xr = (const f32x4*)(x + (size_t)rr[k] * DM) + lane;
#pragma unroll
            for (int j = 0; j < 4; ++j) v[k][j] = __builtin_nontemporal_load(xr + 64 * j); }
#pragma unroll
        for (int k = 0; k < RP_NR; ++k) { float s = 0.f;
#pragma unroll
            for (int j = 0; j < 4; ++j) s += ssq4(v[k][j]);
            const float rs = rsqrtf(wave_sum(s) * (1.0f / DM) + EPS); u32x2* o = (u32x2*)(HBF + (size_t)rr[k] * DM) + lane;
#pragma unroll
            for (int j = 0; j < 4; ++j) o[64 * j] = pk4(v[k][j] * rs * gv[j]); }
    }
}
__device__ __forceinline__ void rowpass1(const float* x, const bf16_t* MF, const float* ssq_m, const float* g1, const float* g2, bf16_t* X1, bf16_t* H2, int gw, int ngw, int lane) {
    f32x4 g1v[4], g2v[4];
#pragma unroll
    for (int j = 0; j < 4; ++j) { g1v[j] = ((const f32x4*)g1)[64 * j + lane]; g2v[j] = ((const f32x4*)g2)[64 * j + lane]; }
    for (int r = gw; r < TG; r += RP_NR * ngw) {
        f32x4 v[RP_NR][4]; u32x2 wv[RP_NR][4]; int rr[RP_NR]; float rm[RP_NR];
#pragma unroll
        for (int k = 0; k < RP_NR; ++k) { rr[k] = (r + k * ngw < TG) ? r + k * ngw : r; const f32x4* xr = (const f32x4*)(x + (size_t)rr[k] * DM) + lane; const u32x2* mr = (const u32x2*)(MF + (size_t)rr[k] * DM) + lane;
            rm[k] = ssq_m[rr[k]];
#pragma unroll
            for (int j = 0; j < 4; ++j) { v[k][j] = __builtin_nontemporal_load(xr + 64 * j); wv[k][j] = __builtin_nontemporal_load(mr + 64 * j); } }
#pragma unroll
        for (int k = 0; k < RP_NR; ++k) { const float rmk = rsqrtf(rm[k] * (1.0f / DM) + EPS); float s = 0.f;
#pragma unroll
            for (int j = 0; j < 4; ++j) { v[k][j] = v[k][j] + unpk4(wv[k][j]) * rmk * g1v[j]; s += ssq4(v[k][j]); }
            const float rs = rsqrtf(wave_sum(s) * (1.0f / DM) + EPS);
            u32x2* orow = (u32x2*)(X1 + (size_t)rr[k] * DM) + lane; u32x2* h = (u32x2*)(H2 + (size_t)rr[k] * DM) + lane;
#pragma unroll
            for (int j = 0; j < 4; ++j) { orow[64 * j] = pk4(v[k][j]); h[64 * j] = pk4(v[k][j] * rs * g2v[j]); } }
    }
}
__device__ __forceinline__ void rowpass2(const bf16_t* X1, const bf16_t* DF, const float* ssq_d, const float* g3, float* out, int gw, int ngw, int lane) {
    f32x4 g3v[4];
#pragma unroll
    for (int j = 0; j < 4; ++j) g3v[j] = ((const f32x4*)g3)[64 * j + lane];
    for (int r = gw; r < TG; r += RP_NR * ngw) {
        u32x2 xv[RP_NR][4]; u32x2 wv[RP_NR][4]; int rr[RP_NR]; float rd[RP_NR];
#pragma unroll
        for (int k = 0; k < RP_NR; ++k) { rr[k] = (r + k * ngw < TG) ? r + k * ngw : r; const u32x2* xr = (const u32x2*)(X1 + (size_t)rr[k] * DM) + lane; const u32x2* dr = (const u32x2*)(DF + (size_t)rr[k] * DM) + lane;
            rd[k] = ssq_d[rr[k]];
#pragma unroll
            for (int j = 0; j < 4; ++j) { xv[k][j] = __builtin_nontemporal_load(xr + 64 * j); wv[k][j] = __builtin_nontemporal_load(dr + 64 * j); } }
        asm volatile("" ::: "memory");
#pragma unroll
        for (int k = 0; k < RP_NR; ++k) { const float rdk = rsqrtf(rd[k] * (1.0f / DM) + EPS); f32x4* orow = (f32x4*)(out + (size_t)rr[k] * DM) + lane;
#pragma unroll
            for (int j = 0; j < 4; ++j) __builtin_nontemporal_store(unpk4(xv[k][j]) + unpk4(wv[k][j]) * rdk * g3v[j], orow + 64 * j); }
    }
}

#define LDS_BARRIER() asm volatile("s_waitcnt lgkmcnt(0)\n\ts_barrier" ::: "memory")
__device__ __forceinline__ void gload16_async(u32x4& r, const void* base, unsigned off) { r = *at<const u32x4>(base, off); }
#define VM_WAIT_N(n) asm volatile("s_waitcnt vmcnt(" #n ")" ::: "memory")
constexpr int AT_KP = 208, AT_VP = 144, AT_KB = 64 * AT_KP, AT_VB = 64 * AT_VP, AT_STAGE = AT_KB + AT_VB;
__device__ __forceinline__ void attn_phase(LAS unsigned char* lds, bf16_t* QN, bf16_t* OUT, const bf16_t* QR, const bf16_t* KN, const bf16_t* KR, const bf16_t* VT, int slog, int nseq, int vcu, int G) {
    int tid_ = threadIdx.x; asm volatile("" : "+v"(tid_));
    const int tid = tid_, w = __builtin_amdgcn_readfirstlane(tid >> 6), grp = w >> 2, lane = tid & 63, qi = lane & 31, hi = lane >> 5;
    const int S = 1 << slog, nqb = S >> 8, nunits = nseq * 8 * nqb, ntile = S >> 6;
    const int lk_row = tid >> 3, lk_c = tid & 7;
    const int lr_row = (tid & 255) >> 2, lr_c = tid & 3;
    const int lv_row = tid >> 3, lv_c = tid & 7;
    if (grp == 1) __builtin_amdgcn_s_setprio(1);
    for (int un = vcu; un < nunits; un += G) {
        const int qb = un % nqb, sh = un / nqb, h = sh & 7, seq = sh >> 3;
        const unsigned tokq = (unsigned)(seq * S + qb * 256 + w * 32 + qi);
        bf16x8 Qf[6];
#pragma unroll
        for (int s = 0; s < 4; ++s) Qf[s] = *at<const bf16x8>(QN, 2u * (tokq * 512u + (unsigned)(64 * h + 16 * s + 8 * hi)));
#pragma unroll
        for (int s = 0; s < 2; ++s) Qf[4 + s] = *at<const bf16x8>(QR, 2u * (tokq * 256u + (unsigned)(32 * h + 16 * s + 8 * hi)));
        f32x16 o0, o1, negm, p0, p1;
#pragma unroll
        for (int i = 0; i < 16; ++i) { o0[i] = 0.f; o1[i] = 0.f; negm[i] = 0.f; p0[i] = 0.f; p1[i] = 0.f; }
        float lsum = 0.f;
        const unsigned kn_off = 2u * (unsigned)((seq * S + lk_row) * 512 + 64 * h + 8 * lk_c);
        const unsigned kr_off = 2u * (unsigned)((seq * S + lr_row) * 32 + 8 * lr_c);
        const unsigned vt_off = 2u * (unsigned)(((seq * 8 + h) * 64 + lv_row) * S + 8 * lv_c);
        u32x4 rk = (u32x4){0u, 0u, 0u, 0u}, rr = rk, rv = rk, rk2 = rk, rr2 = rk, rv2 = rk;
        gload16_async(rk, KN, kn_off); gload16_async(rr, KR, kr_off); gload16_async(rv, VT, vt_off);
        VM_WAIT_N(0);
        LDS_BARRIER();
        *(LAS u32x4*)(lds + lk_row * AT_KP + 16 * lk_c) = rk;
        *(LAS u32x4*)(lds + AT_KB + lv_row * AT_VP + 16 * lv_c) = rv;
        if (tid < 256) *(LAS u32x4*)(lds + lr_row * AT_KP + 128 + 16 * lr_c) = rr;
        gload16_async(rk, KN, kn_off + 65536u); gload16_async(rr, KR, kr_off + 4096u); gload16_async(rv, VT, vt_off + 128u);
        gload16_async(rk2, KN, kn_off + 2u * 65536u); gload16_async(rr2, KR, kr_off + 2u * 4096u); gload16_async(rv2, VT, vt_off + 2u * 128u);
        LDS_BARRIER();
#define AT_H1(T) do { LAS unsigned char* Ks = lds + ((T) & 1) * AT_STAGE; \
            bf16x8 kf[6], kg[6]; \
            _Pragma("unroll") for (int s = 0; s < 3; ++s) { kf[2 * s] = *(const LAS bf16x8*)(Ks + qi * AT_KP + 32 * s + 16 * hi); kf[2 * s + 1] = *(const LAS bf16x8*)(Ks + (32 + qi) * AT_KP + 32 * s + 16 * hi); } \
            __builtin_amdgcn_sched_barrier(0); \
            _Pragma("unroll") for (int s = 3; s < 6; ++s) { kg[2 * (s - 3)] = *(const LAS bf16x8*)(Ks + qi * AT_KP + 32 * s + 16 * hi); kg[2 * (s - 3) + 1] = *(const LAS bf16x8*)(Ks + (32 + qi) * AT_KP + 32 * s + 16 * hi); } \
            p0 = __builtin_amdgcn_mfma_f32_32x32x16_bf16(kf[0], Qf[0], negm, 0, 0, 0); p1 = __builtin_amdgcn_mfma_f32_32x32x16_bf16(kf[1], Qf[0], negm, 0, 0, 0); \
            _Pragma("unroll") for (int s = 1; s < 3; ++s) { p0 = __builtin_amdgcn_mfma_f32_32x32x16_bf16(kf[2 * s], Qf[s], p0, 0, 0, 0); p1 = __builtin_amdgcn_mfma_f32_32x32x16_bf16(kf[2 * s + 1], Qf[s], p1, 0, 0, 0); } \
            __builtin_amdgcn_sched_barrier(0); \
            _Pragma("unroll") for (int s = 3; s < 6; ++s) { p0 = __builtin_amdgcn_mfma_f32_32x32x16_bf16(kg[2 * (s - 3)], Qf[s], p0, 0, 0, 0); p1 = __builtin_amdgcn_mfma_f32_32x32x16_bf16(kg[2 * (s - 3) + 1], Qf[s], p1, 0, 0, 0); } \
        } while (0)
#define AT_H2(T) do { const int t_ = (T); LAS unsigned char* Vs = lds + (t_ & 1) * AT_STAGE + AT_KB; \
            bf16x8 vf[4], vg[4]; \
            _Pragma("unroll") for (int s2 = 0; s2 < 2; ++s2) { vf[2 * s2] = *(const LAS bf16x8*)(Vs + qi * AT_VP + 32 * s2 + 16 * hi); vf[2 * s2 + 1] = *(const LAS bf16x8*)(Vs + (32 + qi) * AT_VP + 32 * s2 + 16 * hi); } \
            __builtin_amdgcn_sched_barrier(0); \
            float mxa = fmaxf(p0[0], p1[0]), mxb = fmaxf(p0[1], p1[1]), mxc = fmaxf(p0[2], p1[2]), mxd = fmaxf(p0[3], p1[3]); \
            _Pragma("unroll") for (int i = 4; i < 16; i += 4) { mxa = fmaxf(mxa, fmaxf(p0[i], p1[i])); mxb = fmaxf(mxb, fmaxf(p0[i + 1], p1[i + 1])); mxc = fmaxf(mxc, fmaxf(p0[i + 2], p1[i + 2])); mxd = fmaxf(mxd, fmaxf(p0[i + 3], p1[i + 3])); } \
            float mx = fmaxf(fmaxf(mxa, mxb), fmaxf(mxc, mxd)); \
            const bool resc = (t_ == 0) || (mx > 8.0f); \
            if (__builtin_amdgcn_ballot_w64(resc) != 0ull) { \
                mx = fmaxf(mx, __shfl_xor(mx, 32)); \
                const float d = (t_ == 0) ? mx : fmaxf(mx, 0.f); const float alpha = (t_ == 0) ? 1.0f : fast_exp2(-d); \
                lsum *= alpha; \
                _Pragma("unroll") for (int i = 0; i < 16; ++i) { o0[i] *= alpha; o1[i] *= alpha; p0[i] -= d; p1[i] -= d; negm[i] -= d; } \
            } \
            float rsa = 0.f, rsb = 0.f, rsc = 0.f, rsd = 0.f; \
            _Pragma("unroll") for (int i = 0; i < 16; i += 4) { \
                p0[i] = fast_exp2(p0[i]); p1[i] = fast_exp2(p1[i]); p0[i + 1] = fast_exp2(p0[i + 1]); p1[i + 1] = fast_exp2(p1[i + 1]); \
                p0[i + 2] = fast_exp2(p0[i + 2]); p1[i + 2] = fast_exp2(p1[i + 2]); p0[i + 3] = fast_exp2(p0[i + 3]); p1[i + 3] = fast_exp2(p1[i + 3]); \
                rsa += p0[i] + p1[i]; rsb += p0[i + 1] + p1[i + 1]; rsc += p0[i + 2] + p1[i + 2]; rsd += p0[i + 3] + p1[i + 3]; } \
            lsum += (rsa + rsb) + (rsc + rsd); \
            bf16x8 pf[2][2]; \
            _Pragma("unroll") for (int s2 = 0; s2 < 2; ++s2) { u32x4 a, b; \
                a.x = pg8::cvt_pk_bf16(p0[8 * s2 + 0], p0[8 * s2 + 1]); a.y = pg8::cvt_pk_bf16(p0[8 * s2 + 2], p0[8 * s2 + 3]); a.z = pg8::cvt_pk_bf16(p0[8 * s2 + 4], p0[8 * s2 + 5]); a.w = pg8::cvt_pk_bf16(p0[8 * s2 + 6], p0[8 * s2 + 7]); \
                b.x = pg8::cvt_pk_bf16(p1[8 * s2 + 0], p1[8 * s2 + 1]); b.y = pg8::cvt_pk_bf16(p1[8 * s2 + 2], p1[8 * s2 + 3]); b.z = pg8::cvt_pk_bf16(p1[8 * s2 + 4], p1[8 * s2 + 5]); b.w = pg8::cvt_pk_bf16(p1[8 * s2 + 6], p1[8 * s2 + 7]); \
                pf[0][s2] = __builtin_bit_cast(bf16x8, a); pf[1][s2] = __builtin_bit_cast(bf16x8, b); } \
            _Pragma("unroll") for (int s2 = 0; s2 < 2; ++s2) { vg[2 * s2] = *(const LAS bf16x8*)(Vs + qi * AT_VP + 64 + 32 * s2 + 16 * hi); vg[2 * s2 + 1] = *(const LAS bf16x8*)(Vs + (32 + qi) * AT_VP + 64 + 32 * s2 + 16 * hi); } \
            _Pragma("unroll") for (int s2 = 0; s2 < 2; ++s2) { o0 = __builtin_amdgcn_mfma_f32_32x32x16_bf16(vf[2 * s2], pf[0][s2], o0, 0, 0, 0); o1 = __builtin_amdgcn_mfma_f32_32x32x16_bf16(vf[2 * s2 + 1], pf[0][s2], o1, 0, 0, 0); } \
            __builtin_amdgcn_sched_barrier(0); \
            _Pragma("unroll") for (int s2 = 0; s2 < 2; ++s2) { o0 = __builtin_amdgcn_mfma_f32_32x32x16_bf16(vg[2 * s2], pf[1][s2], o0, 0, 0, 0); o1 = __builtin_amdgcn_mfma_f32_32x32x16_bf16(vg[2 * s2 + 1], pf[1][s2], o1, 0, 0, 0); } \
        } while (0)
#define AT_FEEDK(TN, RK, RR) do { const int tn_ = (TN); const unsigned tl_ = (unsigned)((tn_ + 2 < ntile) ? tn_ + 2 : ntile - 1); LAS unsigned char* Kn_ = lds + (tn_ & 1) * AT_STAGE; \
            *(LAS u32x4*)(Kn_ + lk_row * AT_KP + 16 * lk_c) = RK; \
            if (tid < 256) *(LAS u32x4*)(Kn_ + lr_row * AT_KP + 128 + 16 * lr_c) = RR; \
            gload16_async(RK, KN, kn_off + tl_ * 65536u); gload16_async(RR, KR, kr_off + tl_ * 4096u); \
            LDS_BARRIER(); } while (0)
#define AT_FEEDV(TN, RV) do { const int tn_ = (TN); const unsigned tl_ = (unsigned)((tn_ + 2 < ntile) ? tn_ + 2 : ntile - 1); LAS unsigned char* Kn_ = lds + (tn_ & 1) * AT_STAGE; \
            *(LAS u32x4*)(Kn_ + AT_KB + lv_row * AT_VP + 16 * lv_c) = RV; \
            gload16_async(RV, VT, vt_off + tl_ * 128u); \
            LDS_BARRIER(); } while (0)
        if (grp == 0) {
            for (int t = 0; t < ntile; t += 2) {
                AT_H1(t); AT_FEEDK(t + 1, rk, rr); AT_H2(t); AT_FEEDV(t + 1, rv);
                AT_H1(t + 1); AT_FEEDK(t + 2, rk2, rr2); AT_H2(t + 1); AT_FEEDV(t + 2, rv2);
            }
            AT_FEEDK(ntile + 1, rk, rr);
        } else {
            AT_FEEDK(1, rk, rr);
            for (int t = 0; t < ntile; t += 2) {
                AT_H1(t); AT_FEEDV(t + 1, rv); AT_H2(t); AT_FEEDK(t + 2, rk2, rr2);
                AT_H1(t + 1); AT_FEEDV(t + 2, rv2); AT_H2(t + 1); AT_FEEDK(t + 3, rk, rr);
            }
        }
#undef AT_FEEDK
#undef AT_FEEDV
#undef AT_H1
#undef AT_H2
        VM_WAIT_N(0);
        lsum += __shfl_xor(lsum, 32);
        const float inv = 1.0f / lsum;
        const unsigned op = 2u * (tokq * 512u + (unsigned)(64 * h + 4 * hi));
#pragma unroll
        for (int g4 = 0; g4 < 4; ++g4) {
            u32x2 a, b;
            a.x = pg8::cvt_pk_bf16(o0[4 * g4 + 0] * inv, o0[4 * g4 + 1] * inv); a.y = pg8::cvt_pk_bf16(o0[4 * g4 + 2] * inv, o0[4 * g4 + 3] * inv);
            b.x = pg8::cvt_pk_bf16(o1[4 * g4 + 0] * inv, o1[4 * g4 + 1] * inv); b.y = pg8::cvt_pk_bf16(o1[4 * g4 + 2] * inv, o1[4 * g4 + 3] * inv);
            *at<u32x2>(OUT, op + 16u * g4) = a; *at<u32x2>(OUT, op + 64u + 16u * g4) = b;
        }
    }
    __builtin_amdgcn_s_setprio(0);
    __syncthreads();
}

constexpr int RA_P = 288;
__device__ __forceinline__ void retA_phase(LAS unsigned char* lds, const bf16_t* RK, const bf16_t* RVT, bf16_t* ST, const float* ldf, const float* ldb, int slog, int nseq, int vcu, int G) {
    int tid_ = threadIdx.x; asm volatile("" : "+v"(tid_));
    const int tid = tid_, w = tid >> 6, lane = tid & 63, r16 = lane & 15, q = lane >> 4;
    const int S = 1 << slog, nch = S >> 7, nunits = nseq * 8 * nch;
    const int var = w >> 2, dvb = (w & 3) * 32;
    const int kq = (w >> 2) * 32 + (lane & 31), key0 = 2 * kq, dseg = ((w & 3) * 2 + (lane >> 5)) * 8;
#define RA_LOAD(UN) do { const int un_ = (UN); const int ch_ = un_ % nch, sh_ = un_ / nch, h_ = sh_ & 7, seq_ = sh_ >> 3; const size_t tokc_ = (size_t)seq_ * S + ch_ * 128; \
        pa = *(const u32x4*)(RK + (tokc_ + key0) * 512 + 64 * h_ + dseg); pb = *(const u32x4*)(RK + (tokc_ + key0 + 1) * 512 + 64 * h_ + dseg); \
        _Pragma("unroll") for (int b2 = 0; b2 < 2; ++b2) _Pragma("unroll") for (int ks = 0; ks < 4; ++ks) \
            pvf[b2][ks] = *(const bf16x8*)(RVT + ((size_t)(seq_ * 8 + h_) * 128 + dvb + 16 * b2 + r16) * S + ch_ * 128 + 32 * ks + 8 * q); } while (0)
    u32x4 pa, pb; bf16x8 pvf[2][4];
    if (vcu < nunits) RA_LOAD(vcu);
    for (int un = vcu; un < nunits; un += G) {
        const int ch = un % nch, sh = un / nch, h = sh & 7, seq = sh >> 3;
        const size_t tokc = (size_t)seq * S + ch * 128;
        const float lgf = ldf[h] * LOG2E, lgb = ldb[h] * LOG2E;
        bf16x8 vf[2][4];
        {
            const u32x4 a = pa, b = pb;
#pragma unroll
            for (int b2 = 0; b2 < 2; ++b2)
#pragma unroll
                for (int ks = 0; ks < 4; ++ks) vf[b2][ks] = pvf[b2][ks];
            const float sf0 = fast_exp2(lgf * (float)(127 - key0)), sf1 = fast_exp2(lgf * (float)(126 - key0)), sb0 = fast_exp2(lgb * (float)key0), sb1 = fast_exp2(lgb * (float)(key0 + 1));
            const int kp = (key0 & ~31) | (8 * ((key0 >> 2) & 3) + 4 * ((key0 >> 4) & 1) + (key0 & 3));
            const unsigned wa[4] = {a.x, a.y, a.z, a.w}, wb[4] = {b.x, b.y, b.z, b.w};
#pragma unroll
            for (int e = 0; e < 4; ++e) { const float a0 = bf_lo(wa[e]), a1 = bf_hi(wa[e]), b0 = bf_lo(wb[e]), b1 = bf_hi(wb[e]);
                LAS unsigned char* r0 = lds + (dseg + 2 * e) * RA_P + 2 * kp;
                *(LAS unsigned*)(r0) = pg8::cvt_pk_bf16(a0 * sf0, b0 * sf1); *(LAS unsigned*)(r0 + RA_P) = pg8::cvt_pk_bf16(a1 * sf0, b1 * sf1);
                *(LAS unsigned*)(r0 + 64 * RA_P) = pg8::cvt_pk_bf16(a0 * sb0, b0 * sb1); *(LAS unsigned*)(r0 + 65 * RA_P) = pg8::cvt_pk_bf16(a1 * sb0, b1 * sb1); }
        }
        __syncthreads();
        if (un + G < nunits) RA_LOAD(un + G);
        f32x4 acc[4][2];
#pragma unroll
        for (int db = 0; db < 4; ++db)
#pragma unroll
            for (int b2 = 0; b2 < 2; ++b2) acc[db][b2] = (f32x4){0.f, 0.f, 0.f, 0.f};
        const LAS unsigned char* Kx = lds + var * 64 * RA_P;
#pragma unroll
        for (int db = 0; db < 4; ++db)
#pragma unroll
            for (int ks = 0; ks < 4; ++ks) { const bf16x8 kf = *(const LAS bf16x8*)(Kx + (16 * db + r16) * RA_P + 64 * ks + 16 * q);
#pragma unroll
                for (int b2 = 0; b2 < 2; ++b2) acc[db][b2] = __builtin_amdgcn_mfma_f32_16x16x32_bf16(kf, vf[b2][ks], acc[db][b2], 0, 0, 0); }
        bf16_t* stp = ST + ((size_t)((tokc >> 7) * 8 + h) * 2 + var) * 8192;
#pragma unroll
        for (int db = 0; db < 4; ++db)
#pragma unroll
            for (int b2 = 0; b2 < 2; ++b2) { u32x2 wv2; wv2.x = pg8::cvt_pk_bf16(acc[db][b2][0], acc[db][b2][1]); wv2.y = pg8::cvt_pk_bf16(acc[db][b2][2], acc[db][b2][3]);
                *(u32x2*)(stp + (dvb + 16 * b2 + r16) * 64 + 16 * db + 4 * q) = wv2; }
        __syncthreads();
    }
#undef RA_LOAD
}
__device__ __forceinline__ void retB_phase(bf16_t* ST, const float* ldf, const float* ldb, int slog, int nseq, long gtid, long gthreads) {
    const int S = 1 << slog, nch = S >> 7; const long items = (long)nseq * 8 * 2 * 1024;
    for (long it = gtid; it < items; it += gthreads) {
        const int vec = (int)(it & 1023), var = (int)((it >> 10) & 1), h = (int)((it >> 11) & 7), seq = (int)(it >> 14);
        const float gam = fast_exp2((var ? ldb[h] : ldf[h]) * LOG2E * 128.0f);
        float run[8];
#pragma unroll
        for (int e = 0; e < 8; ++e) run[e] = 0.f;
        for (int n0 = 0; n0 < nch; n0 += 16) {
            u32x4 v[16]; bf16_t* p[16];
#pragma unroll
            for (int j = 0; j < 16; ++j) { const int n = var ? (nch - 1 - (n0 + j)) : (n0 + j); p[j] = ST + ((size_t)((seq * nch + n) * 8 + h) * 2 + var) * 8192 + vec * 8; v[j] = *(const u32x4*)p[j]; }
#pragma unroll
            for (int j = 0; j < 16; ++j) {
                u32x4 o; o.x = pg8::cvt_pk_bf16(run[0], run[1]); o.y = pg8::cvt_pk_bf16(run[2], run[3]); o.z = pg8::cvt_pk_bf16(run[4], run[5]); o.w = pg8::cvt_pk_bf16(run[6], run[7]);
                *(u32x4*)p[j] = o;
                run[0] = run[0] * gam + bf_lo(v[j].x); run[1] = run[1] * gam + bf_hi(v[j].x); run[2] = run[2] * gam + bf_lo(v[j].y); run[3] = run[3] * gam + bf_hi(v[j].y);
                run[4] = run[4] * gam + bf_lo(v[j].z); run[5] = run[5] * gam + bf_hi(v[j].z); run[6] = run[6] * gam + bf_lo(v[j].w); run[7] = run[7] * gam + bf_hi(v[j].w);
            }
        }
    }
}
constexpr int RC_KP = 160, RC_VP = 288, RC_SP = 160;
constexpr int RC_K = 0, RC_V = 128 * RC_KP, RC_SF = RC_V + 128 * RC_VP, RC_SB = RC_SF + 128 * RC_SP;
__device__ __forceinline__ void retC_phase(LAS unsigned char* lds, const bf16_t* RQ, const bf16_t* RK, const bf16_t* RVT, const bf16_t* ST, const bf16_t* SRG, bf16_t* OB,
                                           const float* ldf, const float* ldb, int slog, int nseq, int vcu, int G) {
    int tid_ = threadIdx.x; asm volatile("" : "+v"(tid_));
    const int tid = tid_, w = tid >> 6, lane = tid & 63, r16 = lane & 15, q = lane >> 4;
    const int S = 1 << slog, nch = S >> 7, nunits = nseq * 8 * nch;
#define RC_LOAD(UN) do { const int un_ = (UN); const int ch_ = un_ % nch, sh_ = un_ / nch, h_ = sh_ & 7, seq_ = sh_ >> 3; const size_t tokc_ = (size_t)seq_ * S + ch_ * 128; \
        _Pragma("unroll") for (int i = 0; i < 2; ++i) { const int id = tid + 512 * i, row = id >> 3, c = id & 7; pk[i] = *(const u32x4*)(RK + (tokc_ + row) * 512 + 64 * h_ + 8 * c); } \
        _Pragma("unroll") for (int i = 0; i < 4; ++i) { const int id = tid + 512 * i, row = id >> 4, c = id & 15; pv[i] = *(const u32x4*)(RVT + ((size_t)(seq_ * 8 + h_) * 128 + row) * S + ch_ * 128 + 8 * c); } \
        const bf16_t* stf_ = ST + ((size_t)((tokc_ >> 7) * 8 + h_) * 2) * 8192; \
        _Pragma("unroll") for (int i = 0; i < 2; ++i) { const int id = tid + 512 * i, row = id >> 3, c = id & 7; psf[i] = *(const u32x4*)(stf_ + row * 64 + 8 * c); psb[i] = *(const u32x4*)(stf_ + 8192 + row * 64 + 8 * c); } \
        _Pragma("unroll") for (int s_ = 0; s_ < 2; ++s_) pq[s_] = *(const bf16x8*)(RQ + (tokc_ + 16 * w + r16) * 512 + 64 * h_ + 32 * s_ + 8 * q); } while (0)
    u32x4 pk[2], pv[4], psf[2], psb[2]; bf16x8 pq[2];
    if (vcu < nunits) RC_LOAD(vcu);
    for (int un = vcu; un < nunits; un += G) {
        const int ch = un % nch, sh = un / nch, h = sh & 7, seq = sh >> 3;
        const size_t tokc = (size_t)seq * S + ch * 128;
        const float lgf = ldf[h] * LOG2E, lgb = ldb[h] * LOG2E;
#pragma unroll
        for (int i = 0; i < 2; ++i) { const int id = tid + 512 * i, row = id >> 3, c = id & 7; *(LAS u32x4*)(lds + RC_K + row * RC_KP + 16 * c) = pk[i]; }
#pragma unroll
        for (int i = 0; i < 4; ++i) { const int id = tid + 512 * i, row = id >> 4, c = id & 15; *(LAS u32x4*)(lds + RC_V + row * RC_VP + 16 * c) = pv[i]; }
#pragma unroll
        for (int i = 0; i < 2; ++i) { const int id = tid + 512 * i, row = id >> 3, c = id & 7;
            *(LAS u32x4*)(lds + RC_SF + row * RC_SP + 16 * c) = psf[i]; *(LAS u32x4*)(lds + RC_SB + row * RC_SP + 16 * c) = psb[i]; }
        bf16x8 Qf[2];
#pragma unroll
        for (int s = 0; s < 2; ++s) Qf[s] = pq[s];
        __syncthreads();
        u32x2 gqv[8];
#pragma unroll
        for (int dvb = 0; dvb < 8; ++dvb) gqv[dvb] = *(const u32x2*)(SRG + (tokc + 16 * w + r16) * 1024 + 128 * h + 16 * dvb + 4 * q);
        if (un + G < nunits) RC_LOAD(un + G);
        const int iq = 16 * w + r16; const size_t tok = tokc + iq;
        bf16x8 pf[4];
#pragma unroll
        for (int ks = 0; ks < 4; ++ks) {
            f32x4 sa[2];
#pragma unroll
            for (int hb = 0; hb < 2; ++hb) { const int kb = 2 * ks + hb; sa[hb] = (f32x4){0.f, 0.f, 0.f, 0.f};
#pragma unroll
                for (int s = 0; s < 2; ++s) { const bf16x8 kf = *(const LAS bf16x8*)(lds + RC_K + (16 * kb + r16) * RC_KP + 64 * s + 16 * q);
                    sa[hb] = __builtin_amdgcn_mfma_f32_16x16x32_bf16(kf, Qf[s], sa[hb], 0, 0, 0); }
#pragma unroll
                for (int i = 0; i < 4; ++i) { const int j = 16 * kb + 4 * q + i; const int df = iq - j; const float arg = (df >= 0) ? lgf * (float)df : lgb * (float)(-df); sa[hb][i] *= fast_exp2(arg); } }
            u32x4 pk; pk.x = pg8::cvt_pk_bf16(sa[0][0], sa[0][1]); pk.y = pg8::cvt_pk_bf16(sa[0][2], sa[0][3]); pk.z = pg8::cvt_pk_bf16(sa[1][0], sa[1][1]); pk.w = pg8::cvt_pk_bf16(sa[1][2], sa[1][3]);
            pf[ks] = __builtin_bit_cast(bf16x8, pk);
        }
        bf16x8 Qff[2], Qfb[2];
        { const float cf = fast_exp2(lgf * (float)(iq + 1)), cb = fast_exp2(lgb * (float)(128 - iq));
#pragma unroll
          for (int s = 0; s < 2; ++s) { const u32x4 qv = __builtin_bit_cast(u32x4, Qf[s]); const unsigned wv[4] = {qv.x, qv.y, qv.z, qv.w}; u32x4 a, b; unsigned ra[4], rb[4];
#pragma unroll
              for (int e = 0; e < 4; ++e) { const float x0 = bf_lo(wv[e]), x1 = bf_hi(wv[e]); ra[e] = pg8::cvt_pk_bf16(x0 * cf, x1 * cf); rb[e] = pg8::cvt_pk_bf16(x0 * cb, x1 * cb); }
              a.x = ra[0]; a.y = ra[1]; a.z = ra[2]; a.w = ra[3]; b.x = rb[0]; b.y = rb[1]; b.z = rb[2]; b.w = rb[3];
              Qff[s] = __builtin_bit_cast(bf16x8, a); Qfb[s] = __builtin_bit_cast(bf16x8, b); } }
        f32x4 oacc[8]; float ss = 0.f;
#pragma unroll
        for (int dvb = 0; dvb < 8; ++dvb) { f32x4 o = (f32x4){0.f, 0.f, 0.f, 0.f};
#pragma unroll
            for (int ks = 0; ks < 4; ++ks) { const bf16x8 vfr = *(const LAS bf16x8*)(lds + RC_V + (16 * dvb + r16) * RC_VP + 64 * ks + 16 * q);
                o = __builtin_amdgcn_mfma_f32_16x16x32_bf16(vfr, pf[ks], o, 0, 0, 0); }
#pragma unroll
            for (int s = 0; s < 2; ++s) { const bf16x8 sf = *(const LAS bf16x8*)(lds + RC_SF + (16 * dvb + r16) * RC_SP + 64 * s + 16 * q);
                const bf16x8 sb = *(const LAS bf16x8*)(lds + RC_SB + (16 * dvb + r16) * RC_SP + 64 * s + 16 * q);
                o = __builtin_amdgcn_mfma_f32_16x16x32_bf16(sf, Qff[s], o, 0, 0, 0);
                o = __builtin_amdgcn_mfma_f32_16x16x32_bf16(sb, Qfb[s], o, 0, 0, 0); }
            oacc[dvb] = o; ss += (o[0] * o[0] + o[1] * o[1]) + (o[2] * o[2] + o[3] * o[3]); }
        ss += __shfl_xor(ss, 16); ss += __shfl_xor(ss, 32);
        const float rstd = rsqrtf(ss * (1.0f / 128.0f) + EPS);
#pragma unroll
        for (int dvb = 0; dvb < 8; ++dvb) { const size_t off = tok * 1024 + 128 * h + 16 * dvb + 4 * q; const u32x2 gq = gqv[dvb];
            const f32x4 o = oacc[dvb]; u32x2 wv2; wv2.x = pg8::cvt_pk_bf16(o[0] * rstd * bf_lo(gq.x), o[1] * rstd * bf_hi(gq.x)); wv2.y = pg8::cvt_pk_bf16(o[2] * rstd * bf_lo(gq.y), o[3] * rstd * bf_hi(gq.y));
            *(u32x2*)(OB + off) = wv2; }
        __syncthreads();
    }
#undef RC_LOAD
}

#define XB_TMO      128
#define XB_XCNT(j)  (256  + 64 * (j))
#define XB_XSUB(j)  (1280 + 64 * (j))
#define XB_XGEN(j)  (2304 + 64 * (j))
#define XB_TOP      3328
#define XB_TOPGEN   3392
#define XCD_BAR_WORDS 3456
#define XB_SPIN_CAP (1u << 18)
__device__ __forceinline__ unsigned xb_ld(unsigned* p)              { return __hip_atomic_load(p, __ATOMIC_RELAXED, __HIP_MEMORY_SCOPE_AGENT); }
__device__ __forceinline__ unsigned xb_add(unsigned* p, unsigned v) { return __hip_atomic_fetch_add(p, v, __ATOMIC_RELAXED, __HIP_MEMORY_SCOPE_AGENT); }
__device__ __forceinline__ unsigned xb_xcc_id() { return (unsigned)__builtin_amdgcn_s_getreg((3 << 11) | 20) & 0xFu; }
#define XB_SPIN(cond, bar) do { unsigned _sp = 0; while (cond) { __builtin_amdgcn_s_sleep(1); \
    if ((++_sp & 255u) == 0u) { if (xb_ld(&(bar)[XB_TMO])) break; if (_sp > XB_SPIN_CAP) { atomicAdd(&(bar)[XB_TMO], 1u); break; } } } } while (0)
struct XcdBarrier { unsigned* bar; unsigned x; volatile LAS unsigned* st; };
__device__ __forceinline__ XcdBarrier xcd_barrier_post(unsigned* bar, volatile LAS unsigned* st) {
    XcdBarrier b; b.bar = bar; b.x = xb_xcc_id(); b.st = st;
    if (threadIdx.x == 0) (void)xb_add(&bar[XB_XCNT(b.x)], 1u);
    return b;
}
__device__ __forceinline__ void xcd_barrier_complete(unsigned* bar, unsigned x, unsigned& nloc, unsigned& nx) {
    const unsigned G = gridDim.x * gridDim.y * gridDim.z;
    unsigned sum, cnt, mine, sp = 0u;
    for (;;) {
        sum = 0u; cnt = 0u; mine = 0u;
#pragma unroll
        for (unsigned j = 0; j < 16; ++j) { const unsigned c = xb_ld(&bar[XB_XCNT(j)]); sum += c; cnt += (c > 0u) ? 1u : 0u; mine = (j == x) ? c : mine; }
        if (sum == G) break;
        __builtin_amdgcn_s_sleep(1);
        if ((++sp & 255u) == 0u) { if (xb_ld(&bar[XB_TMO])) break; if (sp > XB_SPIN_CAP) { atomicAdd(&bar[XB_TMO], 1u); break; } }
    }
    nloc = mine > 0u ? mine : 1u; nx = cnt > 0u ? cnt : 1u;
}
__device__ __forceinline__ void xcd_barrier(const XcdBarrier& b) {
    asm volatile("s_waitcnt vmcnt(0)" ::: "memory");
    __syncthreads();
    if (threadIdx.x == 0) {
        unsigned* bar = b.bar; asm volatile("" : "+s"(bar));
        __builtin_amdgcn_s_waitcnt(0);
        unsigned nloc = b.st[0], nx = b.st[1];
        if (nloc == 0u) { xcd_barrier_complete(bar, b.x, nloc, nx); b.st[0] = nloc; b.st[1] = nx; }
        const unsigned old = xb_add(&bar[XB_XSUB(b.x)], 1u);
        const unsigned gen = old / nloc;
        if (old + 1u == (gen + 1u) * nloc) {
            __builtin_amdgcn_fence(__ATOMIC_RELEASE, "agent");
            asm volatile("s_waitcnt vmcnt(0)" ::: "memory");
            const unsigned og = xb_add(&bar[XB_TOP], 1u);
            const unsigned tg = og / nx;
            if (og + 1u == (tg + 1u) * nx) xb_add(&bar[XB_TOPGEN], 1u);
            else XB_SPIN(xb_ld(&bar[XB_TOPGEN]) == tg, bar);
            __builtin_amdgcn_fence(__ATOMIC_ACQUIRE, "agent");
            xb_add(&bar[XB_XGEN(b.x)], 1u);
            asm volatile("s_waitcnt vmcnt(0)" ::: "memory");
        } else {
            XB_SPIN(xb_ld(&bar[XB_XGEN(b.x)]) == gen, bar);
            __builtin_amdgcn_fence(__ATOMIC_ACQUIRE, "agent");
            asm volatile("s_waitcnt vmcnt(0)" ::: "memory");
        }
    }
    __syncthreads();
}

#define WSP(off) (ws + (off))
#define SSQ ((float*)WSP(WS_SSQ))
#define W1A ((bf16_t*)WSP(WS_W1A))
#define W1B ((bf16_t*)WSP(WS_W1B))
#define WQ ((bf16_t*)WSP(WS_WQ))
#define WKV ((bf16_t*)WSP(WS_WKV))
#define WA ((bf16_t*)WSP(WS_WA))
#define WB ((bf16_t*)WSP(WS_WB))
#define WO ((bf16_t*)WSP(WS_WO))
#define WU ((bf16_t*)WSP(WS_WU))
#define WD ((bf16_t*)WSP(WS_WD))
#define HBF ((bf16_t*)WSP(A_HBF))
#define CQ ((bf16_t*)WSP(A_CQ))
#define CKV ((bf16_t*)WSP(A_CKV))
#define KR ((bf16_t*)WSP(A_KR))
#define RQ ((bf16_t*)WSP(A_RQ))
#define RK ((bf16_t*)WSP(A_RK))
#define RVT ((bf16_t*)WSP(A_RVT))
#define QN ((bf16_t*)WSP(A_QN))
#define QR ((bf16_t*)WSP(A_QR))
#define KN ((bf16_t*)WSP(A_KN))
#define VT ((bf16_t*)WSP(A_VT))
#define ST ((bf16_t*)WSP(A_ST))
#define G3 ((bf16_t*)WSP(A_G3))
#define SRG G3
#define SGA (G3 + (size_t)TG * 1024)
#define SGB (G3 + (size_t)2 * TG * 1024)
#define OB ((bf16_t*)WSP(A_OB))
#define MA ((bf16_t*)WSP(A_MA))
#define MG ((bf16_t*)WSP(A_MG))
#define MF ((bf16_t*)WSP(A_MF))
#define H2 ((bf16_t*)WSP(A_H2))
#define U ((bf16_t*)WSP(A_U))
#define DF ((bf16_t*)WSP(A_DF))
#define X1 ((bf16_t*)WSP(A_X1))
#define SSQP(g, k) (SSQ + (size_t)((g) * 4 + (k)) * TG)
#ifndef PHSEL
#define PHSEL -1
#endif
#define SEL(n) if constexpr (PHSEL < 0 || PHSEL == (n))
#define PHASE_BEGIN ArgsP ap = ap0; asm volatile("" : "+s"(ap)); unsigned char* ws = ap->ws; int tidp = threadIdx.x; asm volatile("" : "+v"(tidp)); \
    const int lane = tidp & 63, wave = tidp >> 6; const int vcu = (G % 8 == 0) ? (bx % 8) * (G / 8) + bx / 8 : bx; const long gtid = (long)bx * 512 + tidp, gthreads = (long)G * 512; const int gw = bx * 8 + wave, ngw = G * 8; \
    const float* xg = (g < 2) ? ap->x_prompt + (size_t)g * TG * DM : ap->x_sample; float* outg = ap->out + (size_t)g * TG * DM; \
    (void)lane; (void)vcu; (void)gtid; (void)gthreads; (void)gw; (void)ngw; (void)xg; (void)outg; (void)ws;

__global__ void __launch_bounds__(512, 2) fwd_megakernel(Args a_unused) {
    extern __shared__ __attribute__((aligned(16))) unsigned char lds_raw[];
    LAS unsigned char* lds = (LAS unsigned char*)lds_raw;
    cg::grid_group grid = cg::this_grid();
    typedef const __attribute__((address_space(4))) Args* ArgsP;
    ArgsP ap0 = (ArgsP)__builtin_amdgcn_kernarg_segment_ptr();
    const int G = gridDim.x, bx = blockIdx.x;
    volatile LAS unsigned* bst = (volatile LAS unsigned*)(lds + 131072 + 64);
    if (threadIdx.x < 2) bst[threadIdx.x] = 0u;
    __syncthreads();
    XcdBarrier xbar = xcd_barrier_post((unsigned*)(ap0->ws + WS_BAR), bst);
#define GSYNC() xcd_barrier(xbar)
    for (int g = 0; g < NGROUPS; ++g) {
        const int slog = (g < 2) ? 11 : 13, nseq = (g < 2) ? 16 : 4;

        if (g == 0) {
        { PHASE_BEGIN
            for (long i = gtid; i < (long)NGROUPS * 4 * TG; i += gthreads) SSQ[i] = 0.f;
            {
                constexpr int I0 = N1A * 16, I1 = N1B * 16, I2 = NQ * 4, I3 = NKV * 2, I4 = 1024 * 8, I5 = 1024 * 16, I6 = 1024 * 16, I7 = 4096 * 16, I8 = 1024 * 64;
                constexpr int ITOT = I0 + I1 + I2 + I3 + I4 + I5 + I6 + I7 + I8;
                for (int it = (int)gtid; it < ITOT; it += (int)gthreads) {
                    int r = it; CW c;
                    if (r < I0) c = CW{ap->w_in, 5536, 1024, N1A, 1, 0, nullptr, W1A};
                    else if ((r -= I0) < I1) c = CW{ap->w_in, 5536, 1024, N1B, 0, 2464, nullptr, W1B};
                    else if ((r -= I1) < I2) c = CW{ap->w_q_up, 768, 256, NQ, 2, 0, ap->g_q_norm, WQ};
                    else if ((r -= I2) < I3) c = CW{ap->w_kv_up, 1024, 128, NKV, 3, 0, ap->g_kv_norm, WKV};
                    else if ((r -= I3) < I4) c = CW{ap->w_branch_a, 1024, 512, 1024, 0, 0, nullptr, WA};
                    else if ((r -= I4) < I5) c = CW{ap->w_branch_b, 1024, 1024, 1024, 0, 0, nullptr, WB};
                    else if ((r -= I5) < I6) c = CW{ap->w_out, 1024, 1024, 1024, 0, 0, nullptr, WO};
                    else if ((r -= I6) < I7) c = CW{ap->w_up, 4096, 1024, 4096, 0, 0, nullptr, WU};
                    else { r -= I7; c = CW{ap->w_down, 1024, 4096, 1024, 0, 0, nullptr, WD}; }
                    convert_item(c, r);
                }
            }
            rowpass0(xg, ap->g_pre_mix, HBF, gw, ngw, lane);
        }
        if (G == 0x7fffffff) grid.sync(); else GSYNC();
        }
        { PHASE_BEGIN
        SEL(1) { pg8::Gemm gm{HBF, W1A, TG, N1A, 1024}; pg8::StaticOrder S; S.init(TG, N1A, G, bx);
          Epi1 E{CQ, CKV, KR, RQ, RK, RVT, SSQP(g, 0), SSQP(g, 1), slog, lds + LDS_TSCR};
          pg8::gemm_phase<Epi1, pg8::StaticOrder, true, true>(lds, gm, S, E); }
        }
        GSYNC();
        { PHASE_BEGIN
        SEL(20) { pg8::Gemm gm{CQ, WQ, TG, NQ, 256}; pg8::StaticOrder S; S.init(TG, NQ, G, bx);
          Epi2q E{QN, QR, SSQP(g, 0), slog};
          pg8::gemm_phase<Epi2q, pg8::StaticOrder, true, true>(lds, gm, S, E); }
        SEL(21) { pg8::Gemm gm{CKV, WKV, TG, NKV, 128}; pg8::StaticOrder S; S.init(TG, NKV, G, bx);
          Epi2kv E{KN, VT, SSQP(g, 1), slog, lds + LDS_TSCR};
          pg8::gemm_phase<Epi2kv, pg8::StaticOrder, true, true>(lds, gm, S, E); }
        SEL(22) retA_phase(lds, RK, RVT, ST, ap->ldf, ap->ldb, slog, nseq, vcu, G);
#ifdef PROBE_RET2
        retA_phase(lds, RK, RVT, ST, ap->ldf, ap->ldb, slog, nseq, vcu, G);
#endif
        }
        GSYNC();
        { PHASE_BEGIN
        SEL(30) retB_phase(ST, ap->ldf, ap->ldb, slog, nseq, gtid, gthreads);
#ifdef PROBE_ATTN2
        attn_phase(lds, QN, OB, QR, KN, KR, VT, slog, nseq, vcu, G);
#endif
        SEL(31) attn_phase(lds, QN, QN, QR, KN, KR, VT, slog, nseq, vcu, G);
        SEL(32) { pg8::Gemm gm{HBF, W1B, TG, N1B, 1024}; pg8::StaticOrder S; S.init(TG, N1B, G, bx);
          EpiAct<1> E{G3, 1024};
          pg8::gemm_phase<EpiAct<1>, pg8::StaticOrder, true, true>(lds, gm, S, E); }
        }
        GSYNC();
        { PHASE_BEGIN
        SEL(40) retC_phase(lds, RQ, RK, RVT, ST, SRG, OB, ap->ldf, ap->ldb, slog, nseq, vcu, G);
#ifdef PROBE_RET2
        retC_phase(lds, RQ, RK, RVT, ST, SRG, OB, ap->ldf, ap->ldb, slog, nseq, vcu, G);
#endif
        SEL(41) { pg8::Gemm gm{QN, WA, TG, 1024, 512}; pg8::StaticOrder S; S.init(TG, 1024, G, bx);
          Epi4 E{SGA, MA};
          pg8::gemm_phase<Epi4, pg8::StaticOrder, true, true>(lds, gm, S, E); }
        }
        GSYNC();
        { PHASE_BEGIN
        SEL(5) { pg8::Gemm gm{OB, WB, TG, 1024, 1024}; pg8::StaticOrder S; S.init(TG, 1024, G, bx);
          Epi5 E{SGB, MA, MG};
          pg8::gemm_phase<Epi5, pg8::StaticOrder, true, true>(lds, gm, S, E); }
        }
        GSYNC();
        { PHASE_BEGIN
        SEL(6) { pg8::Gemm gm{MG, WO, TG, 1024, 1024}; pg8::StaticOrder S; S.init(TG, 1024, G, bx);
          EpiF32Ssq E{MF, SSQP(g, 2)};
          pg8::gemm_phase<EpiF32Ssq, pg8::StaticOrder, true, true>(lds, gm, S, E); }
        }
        GSYNC();
        { PHASE_BEGIN
        SEL(7) rowpass1(xg, MF, SSQP(g, 2), ap->g_post_mix, ap->g_pre_mlp, X1, H2, gw, ngw, lane);
        }
        GSYNC();
        { PHASE_BEGIN
        SEL(8) { pg8::Gemm gm{H2, WU, TG, DFF, 1024}; pg8::StaticOrder S; S.init(TG, DFF, G, bx);
          EpiAct<2> E{U, DFF};
          pg8::gemm_phase<EpiAct<2>, pg8::StaticOrder, true, true>(lds, gm, S, E);
#ifdef PROBE_UP2
          pg8::gemm_phase<EpiAct<2>, pg8::StaticOrder, true, true>(lds, gm, S, E);
#endif
        }
        }
        GSYNC();
        { PHASE_BEGIN
        SEL(9) { pg8::Gemm gm{U, WD, TG, 1024, DFF}; pg8::StaticOrder S; S.init(TG, 1024, G, bx);
          EpiF32Ssq E{DF, SSQP(g, 3)};
          pg8::gemm_phase<EpiF32Ssq, pg8::StaticOrder, true, true>(lds, gm, S, E); }
        }
        GSYNC();
        { PHASE_BEGIN
        SEL(10) rowpass2(X1, DF, SSQP(g, 3), ap->g_post_mlp, outg, gw, ngw, lane);
        if (g + 1 < NGROUPS) { const float* xn = (g + 1 < 2) ? ap->x_prompt + (size_t)(g + 1) * TG * DM : ap->x_sample; rowpass0(xn, ap->g_pre_mix, HBF, gw, ngw, lane); }
        }
        if (g + 1 < NGROUPS) GSYNC();
#ifdef PROBE_SYNC
        for (int i_ = 0; i_ < 10; ++i_) GSYNC();
#endif
    }
}

extern "C" void kernel_launch(void* const* d_in, const int* in_sizes, int n_in, void* d_out, int out_size, void* d_ws, size_t ws_size, hipStream_t stream) {
    static int grid = 0;
    if (grid == 0) {
        if (n_in != 18 || ws_size < WS_NEED) { fprintf(stderr, "kernel_launch: unexpected n_in %d / ws %zu (need %zu)\n", n_in, ws_size, (size_t)WS_NEED); grid = -1; return; }
        int dev = 0, cus = 0, per_cu = 0;
        (void)hipGetDevice(&dev); (void)hipDeviceGetAttribute(&cus, hipDeviceAttributeMultiprocessorCount, dev);
        if (hipFuncSetAttribute((const void*)fwd_megakernel, hipFuncAttributeMaxDynamicSharedMemorySize, LDS_BYTES) != hipSuccess) { fprintf(stderr, "hipFuncSetAttribute failed\n"); grid = -1; return; }
        if (hipOccupancyMaxActiveBlocksPerMultiprocessor(&per_cu, (const void*)fwd_megakernel, 512, LDS_BYTES) != hipSuccess || per_cu < 1) { fprintf(stderr, "occupancy query: %d\n", per_cu); per_cu = 1; }
        (void)hipGetLastError();
        grid = cus;
    }
    if (grid < 0) return;
    Args a{};
    a.x_prompt = (const float*)d_in[0]; a.x_sample = (const float*)d_in[1]; a.g_pre_mix = (const float*)d_in[2]; a.w_in = (const float*)d_in[3];
    a.g_q_norm = (const float*)d_in[4]; a.w_q_up = (const float*)d_in[5]; a.g_kv_norm = (const float*)d_in[6]; a.w_kv_up = (const float*)d_in[7];
    a.w_branch_a = (const float*)d_in[8]; a.ldf = (const float*)d_in[9]; a.ldb = (const float*)d_in[10]; a.w_branch_b = (const float*)d_in[11];
    a.w_out = (const float*)d_in[12]; a.g_post_mix = (const float*)d_in[13]; a.g_pre_mlp = (const float*)d_in[14]; a.w_up = (const float*)d_in[15];
    a.w_down = (const float*)d_in[16]; a.g_post_mlp = (const float*)d_in[17];
    a.out = (float*)d_out; a.ws = (unsigned char*)d_ws;
    if (hipMemsetAsync((char*)d_ws + WS_BAR, 0, 16384, stream) != hipSuccess) { fprintf(stderr, "memset failed\n"); return; }
    void* args[] = {&a};
    hipError_t e = hipLaunchCooperativeKernel((const void*)fwd_megakernel, dim3(grid), dim3(512), args, LDS_BYTES, stream);
    if (e != hipSuccess) fprintf(stderr, "cooperative launch failed: %s (grid %d)\n", hipGetErrorString(e), grid);
}
```

```cpp
#include <hip/hip_runtime.h>
#include <hip/hip_cooperative_groups.h>
#include <cstdio>
#include <cstdint>
namespace cg = cooperative_groups;

#define LAS __attribute__((address_space(3)))
typedef unsigned short bf16_t;
typedef short bf16x8 __attribute__((ext_vector_type(8)));
typedef float f32x4 __attribute__((ext_vector_type(4)));
typedef float f32x16 __attribute__((ext_vector_type(16)));
typedef unsigned u32x4 __attribute__((ext_vector_type(4)));
typedef unsigned u32x2 __attribute__((ext_vector_type(2)));

namespace pg8 {
constexpr int BM = 256, BK = 64, HALF = 128, HTB = HALF * BK * 2, STAGE_BYTES = 8 * HTB, NXCD = 8, WGM = 8;
__host__ __device__ __forceinline__ int lds_byte(int r, int c) { const int st = (r >> 4) * 2 + (c >> 5), rr = r & 15, cc = c & 31, ob = rr * 64 + cc * 2; return st * 1024 + (ob ^ (((ob >> 9) & 1) << 5)); }
__host__ __device__ __forceinline__ void stage_rc(int b, int& R, int& C) { const int st = b / 1024, sb = b % 1024, swz = sb ^ (((sb >> 9) & 1) << 5); R = (st >> 1) * 16 + swz / 64; C = (st & 1) * 32 + (swz % 64) / 2; }
__host__ __device__ __forceinline__ int perm32(int rho) { const int n = rho >> 4, i = rho & 15; return 8 * (i >> 2) + 4 * n + (i & 3); }

struct Unit { int pm, pn; };
struct Gemm { const bf16_t* A; const bf16_t* Bt; int M, N, K; };

struct StaticOrder {
    int nM, nN, nwg, G, c;
    __host__ __device__ void init(int M, int N, int G_, int c_) { nM = M / BM; nN = N / BM; nwg = nM * nN; G = G_; c = c_; }
    __host__ __device__ bool next(int i, Unit& u) const {
        const long L = (long)i * G + c; if (L >= nwg) return false;
        int wgid = (int)L; { const int q = nwg / NXCD, r = nwg % NXCD, xcd = wgid % NXCD, off = wgid / NXCD; wgid = (xcd < r ? xcd * (q + 1) : r * (q + 1) + (xcd - r) * q) + off; }
        const int nig = WGM * nN, gid = wgid / nig, fm = gid * WGM, gsz = (nM - fm) < WGM ? (nM - fm) : WGM;
        u.pm = fm + ((wgid % nig) % gsz); u.pn = (wgid % nig) / gsz; return true;
    }
    __device__ __forceinline__ void a_ready(const Unit&) const {}
    __device__ __forceinline__ void done(const Unit&) const {}
};

__device__ __forceinline__ unsigned cvt_pk_bf16(float lo, float hi) { unsigned r; asm volatile("v_cvt_pk_bf16_f32 %0, %1, %2" : "=v"(r) : "v"(lo), "v"(hi)); return r; }

template <class Epi, class Sched, bool ALIGN_EPI = false, bool SP2 = false>
__device__ __forceinline__ void gemm_phase(LAS unsigned char* lds, const Gemm g, const Sched& S, const Epi& E) {
    int tid_ = threadIdx.x; asm volatile("" : "+v"(tid_));
    const int tid = tid_, wid = __builtin_amdgcn_readfirstlane(tid >> 6), lane = tid & 63, wr = wid >> 2, wc = wid & 3, fr = lane & 15, fq = lane >> 4;
    int K_ = g.K; asm volatile("" : "+s"(K_));
    const int K = K_, nt = K / BK;
    unsigned voffA[2], voffB[2];
#pragma unroll
    for (int i = 0; i < 2; ++i) { int R, C; stage_rc(tid * 16 + i * 8192, R, C); const int Rb = Epi::PERM ? ((R & ~31) + perm32(R & 31)) : R;
        voffA[i] = (unsigned)(R * K + C) * 2u; voffB[i] = (unsigned)(Rb * K + C) * 2u; }
    const size_t kstep = (size_t)(BK * 2);
    const size_t hstep = (size_t)HALF * K * 2;
    const size_t tstep = 2 * hstep;
    const unsigned ldsw = (unsigned)wid * 1024u;
    const int aoff = lds_byte(wr * 64 + fr, fq * 8), boff = lds_byte(wc * 32 + fr, fq * 8);
#define PG8_SA(b, h) (((b) * 2 + (h)) * HTB)
#define PG8_SB(b, h) ((4 + (b) * 2 + (h)) * HTB)
#define PG8_STAGE(bufoff, gbase, voff) do { _Pragma("unroll") for (int _i = 0; _i < 2; ++_i) \
        __builtin_amdgcn_global_load_lds((const unsigned*)((const char*)(gbase) + (voff)[_i]), (LAS unsigned*)(lds + (bufoff) + ldsw + _i * 8192), 16, 0, 0); } while (0)
#define PG8_LDA(dst, b, h) do { _Pragma("unroll") for (int m = 0; m < 4; ++m) _Pragma("unroll") for (int k = 0; k < 2; ++k) dst[m][k] = *(const LAS bf16x8*)(lds + PG8_SA(b, h) + aoff + m * 2048 + k * 1024); } while (0)
#define PG8_LDB(dst, b, h) do { _Pragma("unroll") for (int n = 0; n < 2; ++n) _Pragma("unroll") for (int k = 0; k < 2; ++k) dst[n][k] = *(const LAS bf16x8*)(lds + PG8_SB(b, h) + boff + n * 2048 + k * 1024); } while (0)
#define PG8_MMA(ai, bj, At, Bt) do { __builtin_amdgcn_s_setprio(1); _Pragma("unroll") for (int m = 0; m < 4; ++m) _Pragma("unroll") for (int n = 0; n < 2; ++n) _Pragma("unroll") for (int k = 0; k < 2; ++k) \
        acc[ai][bj][m][n] = __builtin_amdgcn_mfma_f32_16x16x32_bf16(Bt[n][k], At[m][k], acc[ai][bj][m][n], 0, 0, 0); __builtin_amdgcn_s_setprio(0); } while (0)
#define PG8_WAIT_V(n) asm volatile("s_waitcnt vmcnt(" #n ")" ::: "memory")
#define PG8_WAIT_L(n) asm volatile("s_waitcnt lgkmcnt(" #n ")" ::: "memory")
#define PG8_BAR __builtin_amdgcn_s_barrier()
#define PG8_SCHED __builtin_amdgcn_sched_barrier(0)
    Unit cur, nxt; int ui = 0;
    if (!S.next(0, cur)) return;
    f32x4 acc[2][2][4][2];
#pragma unroll
    for (int a = 0; a < 2; ++a)
#pragma unroll
        for (int b = 0; b < 2; ++b)
#pragma unroll
            for (int m = 0; m < 4; ++m)
#pragma unroll
                for (int n = 0; n < 2; ++n) acc[a][b][m][n] = (f32x4){0.f, 0.f, 0.f, 0.f};
    bf16x8 At[4][2], B0[2][2], B1[2][2];
    const char* cA = (const char*)g.A + (size_t)cur.pm * tstep; const char* cB = (const char*)g.Bt + (size_t)cur.pn * tstep;
    S.a_ready(cur);
    if constexpr (SP2) {
        PG8_STAGE(PG8_SB(0, 0), cB, voffB); PG8_STAGE(PG8_SB(0, 1), cB + hstep, voffB); PG8_STAGE(PG8_SA(0, 0), cA, voffA); PG8_STAGE(PG8_SA(0, 1), cA + hstep, voffA);
        if (wr == 1) PG8_BAR;
        PG8_WAIT_V(2); PG8_BAR;
        PG8_STAGE(PG8_SB(1, 0), cB + kstep, voffB); PG8_STAGE(PG8_SA(1, 0), cA + kstep, voffA); PG8_STAGE(PG8_SB(1, 1), cB + hstep + kstep, voffB);
        PG8_WAIT_V(6); PG8_BAR;
    } else {
        PG8_STAGE(PG8_SB(0, 0), cB, voffB); PG8_STAGE(PG8_SA(0, 0), cA, voffA); PG8_STAGE(PG8_SB(0, 1), cB + hstep, voffB); PG8_STAGE(PG8_SA(0, 1), cA + hstep, voffA);
        if (wr == 1) PG8_BAR;
        PG8_WAIT_V(4); PG8_BAR;
        PG8_STAGE(PG8_SB(1, 0), cB + kstep, voffB); PG8_STAGE(PG8_SA(1, 0), cA + kstep, voffA); PG8_STAGE(PG8_SB(1, 1), cB + hstep + kstep, voffB);
        PG8_WAIT_V(6); PG8_BAR;
    }
    for (;;) {
        const bool has_next = S.next(ui + 1, nxt);
        const char* nA = has_next ? (const char*)g.A + (size_t)nxt.pm * tstep : cA; const char* nB = has_next ? (const char*)g.Bt + (size_t)nxt.pn * tstep : cB;
        for (int t = 0; t < nt; t += 2) {
            const bool last = (t == nt - 2);
            const char* a1 = cA + (size_t)(t + 1) * kstep;
            const char* a2 = last ? nA : cA + (size_t)(t + 2) * kstep; const char* b2 = last ? nB : cB + (size_t)(t + 2) * kstep;
            const char* a3 = a2 + kstep; const char* b3 = b2 + kstep;
            if (last && has_next) S.a_ready(nxt);
            if constexpr (SP2) {
            PG8_LDB(B0, 0, 0); PG8_LDB(B1, 0, 1); PG8_SCHED; PG8_LDA(At, 0, 0); PG8_STAGE(PG8_SA(1, 1), a1 + hstep, voffA);
            PG8_WAIT_V(8); PG8_WAIT_L(0); PG8_BAR; PG8_MMA(0, 0, At, B0); PG8_MMA(0, 1, At, B1); PG8_BAR; PG8_SCHED;
            PG8_LDA(At, 0, 1); PG8_STAGE(PG8_SB(0, 0), b2, voffB); PG8_STAGE(PG8_SB(0, 1), b2 + hstep, voffB); PG8_STAGE(PG8_SA(0, 0), a2, voffA);
            PG8_WAIT_V(8); PG8_WAIT_L(0); PG8_BAR; PG8_MMA(1, 0, At, B0); PG8_MMA(1, 1, At, B1); PG8_BAR; PG8_SCHED;
            PG8_LDB(B0, 1, 0); PG8_LDB(B1, 1, 1); PG8_SCHED; PG8_LDA(At, 1, 0); PG8_STAGE(PG8_SA(0, 1), a2 + hstep, voffA);
            PG8_WAIT_V(8); PG8_WAIT_L(0); PG8_BAR; PG8_MMA(0, 0, At, B0); PG8_MMA(0, 1, At, B1); PG8_BAR; PG8_SCHED;
            PG8_LDA(At, 1, 1); PG8_STAGE(PG8_SB(1, 0), b3, voffB); PG8_STAGE(PG8_SB(1, 1), b3 + hstep, voffB); PG8_STAGE(PG8_SA(1, 0), a3, voffA);
            PG8_WAIT_V(8); PG8_WAIT_L(0); PG8_BAR; PG8_MMA(1, 0, At, B0); PG8_MMA(1, 1, At, B1); PG8_BAR; PG8_SCHED;
            } else {
            PG8_LDB(B0, 0, 0); PG8_SCHED; PG8_LDA(At, 0, 0); PG8_STAGE(PG8_SA(1, 1), a1 + hstep, voffA);
            PG8_WAIT_L(8); PG8_BAR; PG8_WAIT_L(0); PG8_MMA(0, 0, At, B0); PG8_BAR; PG8_SCHED;
            PG8_LDB(B1, 0, 1); PG8_STAGE(PG8_SB(0, 0), b2, voffB);
            PG8_BAR; PG8_WAIT_L(0); PG8_MMA(0, 1, At, B1); PG8_BAR;
            PG8_LDA(At, 0, 1); PG8_STAGE(PG8_SA(0, 0), a2, voffA);
            PG8_BAR; PG8_WAIT_L(0); PG8_MMA(1, 0, At, B0); PG8_BAR; PG8_SCHED;
            PG8_STAGE(PG8_SB(0, 1), b2 + hstep, voffB);
            PG8_WAIT_V(6); PG8_BAR; PG8_MMA(1, 1, At, B1); PG8_BAR;
            PG8_LDB(B0, 1, 0); PG8_SCHED; PG8_LDA(At, 1, 0); PG8_STAGE(PG8_SA(0, 1), a2 + hstep, voffA);
            PG8_WAIT_L(8); PG8_BAR; PG8_WAIT_L(0); PG8_MMA(0, 0, At, B0); PG8_BAR; PG8_SCHED;
            PG8_LDB(B1, 1, 1); PG8_STAGE(PG8_SB(1, 0), b3, voffB);
            PG8_BAR; PG8_WAIT_L(0); PG8_MMA(0, 1, At, B1); PG8_BAR;
            PG8_LDA(At, 1, 1); PG8_STAGE(PG8_SA(1, 0), a3, voffA);
            PG8_BAR; PG8_WAIT_L(0); PG8_MMA(1, 0, At, B0); PG8_BAR; PG8_SCHED;
            PG8_STAGE(PG8_SB(1, 1), b3 + hstep, voffB);
            PG8_WAIT_V(6); PG8_BAR; PG8_MMA(1, 1, At, B1); PG8_BAR;
            }
        }
        if constexpr (ALIGN_EPI) { if (wr == 0) PG8_BAR; }
        E(acc, cur, wr, wc, fr, fq);
        if (!has_next) break;
#pragma unroll
        for (int a = 0; a < 2; ++a)
#pragma unroll
            for (int b = 0; b < 2; ++b)
#pragma unroll
                for (int m = 0; m < 4; ++m)
#pragma unroll
                    for (int n = 0; n < 2; ++n) acc[a][b][m][n] = (f32x4){0.f, 0.f, 0.f, 0.f};
        cur = nxt; cA = nA; cB = nB; ++ui;
        if constexpr (ALIGN_EPI) { if (wr == 1) PG8_BAR; }
    }
    PG8_WAIT_V(0);
    if constexpr (!ALIGN_EPI) { if (wr == 0) PG8_BAR; }
    PG8_BAR;
#undef PG8_SA
#undef PG8_SB
#undef PG8_STAGE
#undef PG8_LDA
#undef PG8_LDB
#undef PG8_MMA
#undef PG8_WAIT_V
#undef PG8_WAIT_L
#undef PG8_BAR
#undef PG8_SCHED
}
}

constexpr int DM = 1024, TG = 32768, NGROUPS = 3, DFF = 4096;
constexpr int N1A = 2560, N1B = 3072, NQ = 768, NKV = 1024;
constexpr float EPS = 1e-6f;
constexpr float LOG2E = 1.4426950408889634f;
constexpr float QSCALE = 0.10206207261596575f * LOG2E;
constexpr float LOG2_THETA = 13.287712379549449f;
constexpr float INV_2PI = 0.15915494309189535f;

constexpr size_t MiB = 1u << 20;
constexpr size_t WS_SSQ = 0;
constexpr size_t WS_BAR = 1792 * 1024;
constexpr size_t WS_W1A = 2 * MiB;
constexpr size_t WS_W1B = 7 * MiB;
constexpr size_t WS_WQ = 13 * MiB;
constexpr size_t WS_WKV = 13 * MiB + 512 * 1024;
constexpr size_t WS_WA = 14 * MiB;
constexpr size_t WS_WB = 15 * MiB;
constexpr size_t WS_WO = 17 * MiB;
constexpr size_t WS_WU = 19 * MiB;
constexpr size_t WS_WD = 27 * MiB;
constexpr size_t WS_ACT = 40 * MiB;
constexpr size_t A_HBF = WS_ACT + 0 * MiB, A_CQ = WS_ACT + 64 * MiB, A_CKV = WS_ACT + 80 * MiB, A_KR = WS_ACT + 88 * MiB;
constexpr size_t A_RQ = WS_ACT + 96 * MiB, A_RK = WS_ACT + 128 * MiB, A_RVT = WS_ACT + 160 * MiB, A_QN = WS_ACT + 224 * MiB;
constexpr size_t A_QR = WS_ACT + 256 * MiB, A_KN = WS_ACT + 272 * MiB, A_VT = WS_ACT + 304 * MiB, A_ST = WS_ACT + 336 * MiB;
constexpr size_t A_G3 = WS_ACT + 400 * MiB;
constexpr size_t A_OB = WS_ACT + 592 * MiB, A_MA = WS_ACT + 656 * MiB, A_MG = WS_ACT + 784 * MiB;
constexpr size_t A_MF = WS_ACT + 0 * MiB, A_H2 = WS_ACT + 128 * MiB, A_U = WS_ACT + 192 * MiB, A_DF = WS_ACT + 448 * MiB;
constexpr size_t A_X1 = WS_ACT + 512 * MiB;
constexpr size_t WS_NEED = WS_ACT + 848 * MiB;

constexpr int LDS_BYTES = 155648;
constexpr int LDS_TSCR = 131328, TS_P = 80;

__device__ __forceinline__ float bf_lo(unsigned u) { return __uint_as_float(u << 16); }
__device__ __forceinline__ float bf_hi(unsigned u) { return __uint_as_float(u & 0xffff0000u); }
__device__ __forceinline__ bf16_t f2bf(float f) { return (bf16_t)(pg8::cvt_pk_bf16(f, f) & 0xffffu); }
__device__ __forceinline__ float wave_sum(float v) {
#pragma unroll
    for (int o = 1; o < 64; o <<= 1) v += __shfl_xor(v, o);
    return v;
}
__device__ __forceinline__ float fast_exp2(float x) { return __builtin_amdgcn_exp2f(x); }
__device__ __forceinline__ float sigmoidf_(float v) { return __builtin_amdgcn_rcpf(1.0f + fast_exp2(-v * LOG2E)); }
__device__ __forceinline__ void sincos_rev(float pos, float invf, float& s, float& c) {
    const float ang = pos * invf; const float fr = __builtin_amdgcn_fractf(ang * INV_2PI);
    s = __builtin_amdgcn_sinf(fr); c = __builtin_amdgcn_cosf(fr);
}
__device__ __forceinline__ void atomic_addf(float* p, float v) { __hip_atomic_fetch_add(p, v, __ATOMIC_RELAXED, __HIP_MEMORY_SCOPE_AGENT); }
__device__ __forceinline__ u32x4 pack8(const f32x4& a, const f32x4& b) {
    u32x4 w; w.x = pg8::cvt_pk_bf16(a[0], a[1]); w.y = pg8::cvt_pk_bf16(a[2], a[3]); w.z = pg8::cvt_pk_bf16(b[0], b[1]); w.w = pg8::cvt_pk_bf16(b[2], b[3]); return w;
}

typedef f32x4 AccT[2][2][4][2];
template <class T> __device__ __forceinline__ T* at(const void* base, unsigned byteoff) { return (T*)((char*)base + byteoff); }

struct Epi1 {
    static constexpr bool PERM = true;
    bf16_t *CQ, *CKV, *KR, *RQ, *RK, *RVT; float *ssq_q, *ssq_kv; int slog; LAS unsigned char* tscr;
    __device__ __forceinline__ void operator()(const AccT& acc, const pg8::Unit& u, int wr, int wc, int fr, int fq) const {
        asm volatile("" : "+v"(fr), "+v"(fq), "+s"(wr), "+s"(wc));
        const int pn = u.pn, S = 1 << slog; const int rowb = u.pm * 256 + wr * 64 + fr;
        if (pn == 0) {
#pragma unroll
            for (int ai = 0; ai < 2; ++ai)
#pragma unroll
                for (int m = 0; m < 4; ++m) { const int row = rowb + ai * 128 + m * 16; float s = 0.f;
#pragma unroll
                    for (int bj = 0; bj < 2; ++bj) { const f32x4 v0 = acc[ai][bj][m][0], v1 = acc[ai][bj][m][1];
                        s += (v0[0] * v0[0] + v0[1] * v0[1]) + (v0[2] * v0[2] + v0[3] * v0[3]) + (v1[0] * v1[0] + v1[1] * v1[1]) + (v1[2] * v1[2] + v1[3] * v1[3]);
                        *at<u32x4>(CQ, 2u * (unsigned)(row * 256 + bj * 128 + wc * 32 + 8 * fq)) = pack8(v0, v1); }
                    s += __shfl_xor(s, 16); s += __shfl_xor(s, 32);
                    if (fq == 0) atomic_addf(at<float>(ssq_q, 4u * (unsigned)row), s); }
        } else if (pn == 1) {
            float invf[4];
#pragma unroll
            for (int j = 0; j < 4; ++j) invf[j] = fast_exp2(-(float)(4 * fq + j) * (LOG2_THETA / 16.0f));
#pragma unroll
            for (int ai = 0; ai < 2; ++ai)
#pragma unroll
                for (int m = 0; m < 4; ++m) { const int row = rowb + ai * 128 + m * 16;
                    { const f32x4 v0 = acc[ai][0][m][0], v1 = acc[ai][0][m][1];
                      float s = (v0[0] * v0[0] + v0[1] * v0[1]) + (v0[2] * v0[2] + v0[3] * v0[3]) + (v1[0] * v1[0] + v1[1] * v1[1]) + (v1[2] * v1[2] + v1[3] * v1[3]);
                      *at<u32x4>(CKV, 2u * (unsigned)(row * 128 + wc * 32 + 8 * fq)) = pack8(v0, v1);
                      s += __shfl_xor(s, 16); s += __shfl_xor(s, 32);
                      if (fq == 0) atomic_addf(at<float>(ssq_kv, 4u * (unsigned)row), s); }
                    if (wc == 0) { const f32x4 x1 = acc[ai][1][m][0], x2 = acc[ai][1][m][1]; const float pos = (float)(row & (S - 1)); f32x4 o1, o2;
#pragma unroll
                        for (int j = 0; j < 4; ++j) { float sn, cs; sincos_rev(pos, invf[j], sn, cs); o1[j] = x1[j] * cs - x2[j] * sn; o2[j] = x1[j] * sn + x2[j] * cs; }
                        *at<u32x4>(KR, 2u * (unsigned)(row * 32 + 8 * fq)) = pack8(o1, o2); } }
        } else if (pn <= 5) {
            const bool isk = pn >= 4; bf16_t* dst = isk ? RK : RQ; const float sc = isk ? 0.125f : 1.0f; const int colt = (pn & 1) * 256;
            const int g = (wc & 1) * 4 + fq; float invf[4];
#pragma unroll
            for (int j = 0; j < 4; ++j) invf[j] = fast_exp2(-(float)(4 * g + j) * (LOG2_THETA / 32.0f));
#pragma unroll
            for (int ai = 0; ai < 2; ++ai)
#pragma unroll
                for (int m = 0; m < 4; ++m) { const int row = rowb + ai * 128 + m * 16; const float pos = (float)(row & (S - 1)); float sn[4], cs[4];
#pragma unroll
                    for (int j = 0; j < 4; ++j) sincos_rev(pos, invf[j], sn[j], cs[j]);
#pragma unroll
                    for (int bj = 0; bj < 2; ++bj) { const f32x4 x1 = acc[ai][bj][m][0], x2 = acc[ai][bj][m][1]; f32x4 o1, o2;
#pragma unroll
                        for (int j = 0; j < 4; ++j) { o1[j] = (x1[j] * cs[j] - x2[j] * sn[j]) * sc; o2[j] = (x1[j] * sn[j] + x2[j] * cs[j]) * sc; }
                        *at<u32x4>(dst, 2u * (unsigned)(row * 512 + colt + bj * 128 + wc * 32 + 8 * fq)) = pack8(o1, o2); } }
        } else {
            LAS unsigned char* tl = tscr + (wr * 4 + wc) * (32 * TS_P); const int lane = fq * 16 + fr, rdv = lane >> 1, rh = lane & 1;
#pragma unroll
            for (int ai = 0; ai < 2; ++ai)
#pragma unroll
                for (int mp = 0; mp < 2; ++mp)
#pragma unroll
                    for (int bj = 0; bj < 2; ++bj) {
#pragma unroll
                        for (int mm = 0; mm < 2; ++mm) { const int p = 8 * (fr >> 2) + 4 * mm + (fr & 3);
#pragma unroll
                            for (int n = 0; n < 2; ++n)
#pragma unroll
                                for (int j = 0; j < 4; ++j) *(LAS bf16_t*)(tl + (8 * fq + 4 * n + j) * TS_P + 2 * p) = f2bf(acc[ai][bj][2 * mp + mm][n][j]); }
                        const u32x4 q0 = *(const LAS u32x4*)(tl + rdv * TS_P + 32 * rh), q1 = *(const LAS u32x4*)(tl + rdv * TS_P + 32 * rh + 16);
                        const int tokb = u.pm * 256 + ai * 128 + wr * 64 + 32 * mp; const int seq = tokb >> slog, posb = tokb & (S - 1);
                        const int colb = (pn - 6) * 256 + bj * 128 + wc * 32; const int head = colb >> 7, dvh = colb & 127;
                        const unsigned gb = 2u * (unsigned)(((seq * 8 + head) * 128 + dvh + rdv) * S + posb + 16 * rh);
                        *at<u32x4>(RVT, gb) = q0; *at<u32x4>(RVT, gb + 16u) = q1; }
        }
    }
};

struct Epi2q {
    static constexpr bool PERM = true;
    bf16_t *QN, *QR; const float* ssq_q; int slog;
    __device__ __forceinline__ void operator()(const AccT& acc, const pg8::Unit& u, int wr, int wc, int fr, int fq) const {
        asm volatile("" : "+v"(fr), "+v"(fq), "+s"(wr), "+s"(wc));
        const int pn = u.pn, S = 1 << slog; const int rowb = u.pm * 256 + wr * 64 + fr;
        float invf[4];
#pragma unroll
        for (int j = 0; j < 4; ++j) invf[j] = fast_exp2(-(float)(4 * fq + j) * (LOG2_THETA / 16.0f));
#pragma unroll
        for (int ai = 0; ai < 2; ++ai)
#pragma unroll
            for (int m = 0; m < 4; ++m) { const int row = rowb + ai * 128 + m * 16; const float f = rsqrtf(*at<const float>(ssq_q, 4u * (unsigned)row) * (1.0f / 256.0f) + EPS) * QSCALE;
                if (pn < 2) {
#pragma unroll
                    for (int bj = 0; bj < 2; ++bj) *at<u32x4>(QN, 2u * (unsigned)(row * 512 + pn * 256 + bj * 128 + wc * 32 + 8 * fq)) = pack8(acc[ai][bj][m][0] * f, acc[ai][bj][m][1] * f);
                } else { const float pos = (float)(row & (S - 1)); float sn[4], cs[4];
#pragma unroll
                    for (int j = 0; j < 4; ++j) sincos_rev(pos, invf[j], sn[j], cs[j]);
#pragma unroll
                    for (int bj = 0; bj < 2; ++bj) { const f32x4 x1 = acc[ai][bj][m][0], x2 = acc[ai][bj][m][1]; f32x4 o1, o2;
#pragma unroll
                        for (int j = 0; j < 4; ++j) { o1[j] = (x1[j] * cs[j] - x2[j] * sn[j]) * f; o2[j] = (x1[j] * sn[j] + x2[j] * cs[j]) * f; }
                        *at<u32x4>(QR, 2u * (unsigned)(row * 256 + bj * 128 + wc * 32 + 8 * fq)) = pack8(o1, o2); } } }
    }
};

struct Epi2kv {
    static constexpr bool PERM = true;
    bf16_t *KN, *VT; const float* ssq_kv; int slog; LAS unsigned char* tscr;
    __device__ __forceinline__ void operator()(const AccT& acc, const pg8::Unit& u, int wr, int wc, int fr, int fq) const {
        asm volatile("" : "+v"(fr), "+v"(fq), "+s"(wr), "+s"(wc));
        const int pn = u.pn, S = 1 << slog; const int rowb = u.pm * 256 + wr * 64 + fr;
        if (pn < 2) {
#pragma unroll
            for (int ai = 0; ai < 2; ++ai)
#pragma unroll
                for (int m = 0; m < 4; ++m) { const int row = rowb + ai * 128 + m * 16; const float f = rsqrtf(*at<const float>(ssq_kv, 4u * (unsigned)row) * (1.0f / 128.0f) + EPS);
#pragma unroll
                    for (int bj = 0; bj < 2; ++bj) *at<u32x4>(KN, 2u * (unsigned)(row * 512 + pn * 256 + bj * 128 + wc * 32 + 8 * fq)) = pack8(acc[ai][bj][m][0] * f, acc[ai][bj][m][1] * f); }
        } else {
            LAS unsigned char* tl = tscr + (wr * 4 + wc) * (32 * TS_P); const int lane = fq * 16 + fr, rdv = lane >> 1, rh = lane & 1;
            const int p16 = 8 * ((fr >> 2) & 1) + 4 * (fr >> 3) + (fr & 3);
#pragma unroll
            for (int ai = 0; ai < 2; ++ai)
#pragma unroll
                for (int mp = 0; mp < 2; ++mp) {
                    float f[2];
#pragma unroll
                    for (int mm = 0; mm < 2; ++mm) f[mm] = rsqrtf(*at<const float>(ssq_kv, 4u * (unsigned)(rowb + ai * 128 + (2 * mp + mm) * 16)) * (1.0f / 128.0f) + EPS);
#pragma unroll
                    for (int bj = 0; bj < 2; ++bj) {
#pragma unroll
                        for (int mm = 0; mm < 2; ++mm) { const int p = 16 * mm + p16;
#pragma unroll
                            for (int n = 0; n < 2; ++n)
#pragma unroll
                                for (int j = 0; j < 4; ++j) *(LAS bf16_t*)(tl + (8 * fq + 4 * n + j) * TS_P + 2 * p) = f2bf(acc[ai][bj][2 * mp + mm][n][j] * f[mm]); }
                        const u32x4 q0 = *(const LAS u32x4*)(tl + rdv * TS_P + 32 * rh), q1 = *(const LAS u32x4*)(tl + rdv * TS_P + 32 * rh + 16);
                        const int tokb = u.pm * 256 + ai * 128 + wr * 64 + 32 * mp; const int seq = tokb >> slog, posb = tokb & (S - 1);
                        const int colb = (pn - 2) * 256 + bj * 128 + wc * 32; const int head = colb >> 6, dvh = colb & 63;
                        const unsigned gb = 2u * (unsigned)(((seq * 8 + head) * 64 + dvh + rdv) * S + posb + 16 * rh);
                        *at<u32x4>(VT, gb) = q0; *at<u32x4>(VT, gb + 16u) = q1; } }
        }
    }
};

template <int ACT> struct EpiAct {
    static constexpr bool PERM = true;
    bf16_t* O; int ldc; const float* rs2;
    __device__ __forceinline__ void operator()(const AccT& acc, const pg8::Unit& u, int wr, int wc, int fr, int fq) const {
        asm volatile("" : "+v"(fr), "+v"(fq), "+s"(wr), "+s"(wc));
        const int rowb = u.pm * 256 + wr * 64 + fr; int colt = u.pn * 256; unsigned boff = 0u; bool silu = false;
        if (ACT == 1) { const int t = u.pn >> 2; boff = (unsigned)t * (unsigned)(TG * 1024 * 2); colt = (u.pn & 3) * 256; silu = (t == 0); }
#pragma unroll
        for (int ai = 0; ai < 2; ++ai)
#pragma unroll
            for (int m = 0; m < 4; ++m) { const int row = rowb + ai * 128 + m * 16; float rsq = 1.0f; if (ACT == 2) rsq = *at<const float>(rs2, 4u * (unsigned)row);
#pragma unroll
                for (int bj = 0; bj < 2; ++bj) { f32x4 v[2] = {acc[ai][bj][m][0], acc[ai][bj][m][1]};
#pragma unroll
                    for (int n = 0; n < 2; ++n)
#pragma unroll
                        for (int j = 0; j < 4; ++j) { const float x = v[n][j];
                            if (ACT == 1) { const float sg = sigmoidf_(x); v[n][j] = silu ? x * sg : sg; }
                            else { const float r = fmaxf(x, 0.f); v[n][j] = r * r * rsq; } }
                    *at<u32x4>(O, boff + 2u * (unsigned)(row * ldc + colt + bj * 128 + wc * 32 + 8 * fq)) = pack8(v[0], v[1]); } }
    }
};

struct Epi4 {
    static constexpr bool PERM = true;
    const bf16_t* SGA; bf16_t* MA;
    __device__ __forceinline__ void operator()(const AccT& acc, const pg8::Unit& u, int wr, int wc, int fr, int fq) const {
        asm volatile("" : "+v"(fr), "+v"(fq), "+s"(wr), "+s"(wc));
        const int rowb = u.pm * 256 + wr * 64 + fr;
#pragma unroll
        for (int ai = 0; ai < 2; ++ai)
#pragma unroll
            for (int m = 0; m < 4; ++m) { const int row = rowb + ai * 128 + m * 16;
#pragma unroll
                for (int bj = 0; bj < 2; ++bj) { const unsigned off = (unsigned)(row * 1024 + u.pn * 256 + bj * 128 + wc * 32 + 8 * fq);
                    const u32x4 gq = *at<const u32x4>(SGA, 2u * off); const f32x4 a0 = acc[ai][bj][m][0], a1 = acc[ai][bj][m][1];
                    f32x4 o0, o1; o0[0] = a0[0] * bf_lo(gq.x); o0[1] = a0[1] * bf_hi(gq.x); o0[2] = a0[2] * bf_lo(gq.y); o0[3] = a0[3] * bf_hi(gq.y);
                    o1[0] = a1[0] * bf_lo(gq.z); o1[1] = a1[1] * bf_hi(gq.z); o1[2] = a1[2] * bf_lo(gq.w); o1[3] = a1[3] * bf_hi(gq.w);
                    *at<u32x4>(MA, 2u * off) = pack8(o0, o1); } }
    }
};
struct Epi5 {
    static constexpr bool PERM = true;
    const bf16_t* SGB; const bf16_t* MA; bf16_t* MG;
    __device__ __forceinline__ void operator()(const AccT& acc, const pg8::Unit& u, int wr, int wc, int fr, int fq) const {
        asm volatile("" : "+v"(fr), "+v"(fq), "+s"(wr), "+s"(wc));
        const int rowb = u.pm * 256 + wr * 64 + fr;
#pragma unroll
        for (int ai = 0; ai < 2; ++ai)
#pragma unroll
            for (int m = 0; m < 4; ++m) { const int row = rowb + ai * 128 + m * 16;
#pragma unroll
                for (int bj = 0; bj < 2; ++bj) { const unsigned off = (unsigned)(row * 1024 + u.pn * 256 + bj * 128 + wc * 32 + 8 * fq);
                    const u32x4 gq = *at<const u32x4>(SGB, 2u * off); const f32x4 a0 = acc[ai][bj][m][0], a1 = acc[ai][bj][m][1];
                    const u32x4 mq = *at<const u32x4>(MA, 2u * off); f32x4 o0 = (f32x4){bf_lo(mq.x), bf_hi(mq.x), bf_lo(mq.y), bf_hi(mq.y)}, o1 = (f32x4){bf_lo(mq.z), bf_hi(mq.z), bf_lo(mq.w), bf_hi(mq.w)};
                    o0[0] += a0[0] * bf_lo(gq.x); o0[1] += a0[1] * bf_hi(gq.x); o0[2] += a0[2] * bf_lo(gq.y); o0[3] += a0[3] * bf_hi(gq.y);
                    o1[0] += a1[0] * bf_lo(gq.z); o1[1] += a1[1] * bf_hi(gq.z); o1[2] += a1[2] * bf_lo(gq.w); o1[3] += a1[3] * bf_hi(gq.w);
                    *at<u32x4>(MG, 2u * off) = pack8(o0, o1); } }
    }
};
struct EpiF32Ssq {
    static constexpr bool PERM = true;
    bf16_t* O; float* ssq;
    __device__ __forceinline__ void operator()(const AccT& acc, const pg8::Unit& u, int wr, int wc, int fr, int fq) const {
        asm volatile("" : "+v"(fr), "+v"(fq), "+s"(wr), "+s"(wc));
        const int rowb = u.pm * 256 + wr * 64 + fr;
#pragma unroll
        for (int ai = 0; ai < 2; ++ai)
#pragma unroll
            for (int m = 0; m < 4; ++m) { const int row = rowb + ai * 128 + m * 16; float s = 0.f;
#pragma unroll
                for (int bj = 0; bj < 2; ++bj) { const unsigned off = (unsigned)(row * 1024 + u.pn * 256 + bj * 128 + wc * 32 + 8 * fq); const f32x4 v0 = acc[ai][bj][m][0], v1 = acc[ai][bj][m][1];
                    s += (v0[0] * v0[0] + v0[1] * v0[1]) + (v0[2] * v0[2] + v0[3] * v0[3]) + (v1[0] * v1[0] + v1[1] * v1[1]) + (v1[2] * v1[2] + v1[3] * v1[3]);
                    *at<u32x4>(O, 2u * off) = pack8(v0, v1); }
                s += __shfl_xor(s, 16); s += __shfl_xor(s, 32);
                if (fq == 0) atomic_addf(at<float>(ssq, 4u * (unsigned)row), s); }
    }
};

struct Args {
    const float* x_prompt; const float* x_sample; const float* g_pre_mix; const float* w_in; const float* g_q_norm; const float* w_q_up;
    const float* g_kv_norm; const float* w_kv_up; const float* w_branch_a; const float* ldf; const float* ldb; const float* w_branch_b;
    const float* w_out; const float* g_post_mix; const float* g_pre_mlp; const float* w_up; const float* w_down; const float* g_post_mlp;
    float* out; unsigned char* ws;
};

__device__ __forceinline__ int src_col(int mode, int n, int coff) {
    if (mode == 0) return coff + n;
    if (mode == 1) {
        if (n < 256) return n;
        if (n < 384) return n;
        if (n < 416) { const int c = n - 384; return 384 + 16 * ((c >> 2) & 1) + 4 * (c >> 3) + (c & 3); }
        if (n < 512) return -1;
        if (n < 1536) { const int c = (n - 512) & 511, base = (n < 1024) ? 416 : 928; const int head = c >> 6, w = c & 63; return base + 64 * head + 32 * ((w >> 2) & 1) + 4 * (w >> 3) + (w & 3); }
        return 1440 + (n - 1536);
    }
    if (mode == 2) {
        if (n < 512) return 96 * (n >> 6) + (n & 63);
        const int c = n - 512, head = c >> 5, w = c & 31; return 96 * head + 64 + 16 * ((w >> 2) & 1) + 4 * (w >> 3) + (w & 3);
    }
    if (n < 512) return 128 * (n >> 6) + (n & 63);
    { const int c = n - 512; return 128 * (c >> 6) + 64 + (c & 63); }
}
struct CW { const float* W; int ldw, K, Nout, mode, coff; const float* gk; bf16_t* out; };
__device__ __forceinline__ void convert_item(const CW& c, int it) {
    const int n = it % c.Nout, kb = (it / c.Nout) * 64; const int sc = src_col(c.mode, n, c.coff);
#pragma unroll 2
    for (int sub = 0; sub < 8; ++sub) { const int k0 = kb + 8 * sub;
        float v[8];
#pragma unroll
        for (int e = 0; e < 8; ++e) { float x = (sc >= 0) ? c.W[(size_t)(k0 + e) * c.ldw + sc] : 0.f; if (c.gk) x *= c.gk[k0 + e]; v[e] = x; }
        u32x4 w; w.x = pg8::cvt_pk_bf16(v[0], v[1]); w.y = pg8::cvt_pk_bf16(v[2], v[3]); w.z = pg8::cvt_pk_bf16(v[4], v[5]); w.w = pg8::cvt_pk_bf16(v[6], v[7]);
        *(u32x4*)(c.out + (size_t)n * c.K + k0) = w; }
}

__device__ __forceinline__ float ssq4(const f32x4& v) { return (v[0] * v[0] + v[1] * v[1]) + (v[2] * v[2] + v[3] * v[3]); }
__device__ __forceinline__ u32x2 pk4(const f32x4& y) { u32x2 w; w.x = pg8::cvt_pk_bf16(y[0], y[1]); w.y = pg8::cvt_pk_bf16(y[2], y[3]); return w; }
__device__ __forceinline__ f32x4 unpk4(const u32x2& w) { return (f32x4){bf_lo(w.x), bf_hi(w.x), bf_lo(w.y), bf_hi(w.y)}; }
constexpr int RP_NR = 2;
__device__ __forceinline__ void rowpass0(const float* x, const float* g, bf16_t* HBF, int gw, int ngw, int lane) {
    f32x4 gv[4];
#pragma unroll
    for (int j = 0; j < 4; ++j) gv[j] = ((const f32x4*)g)[64 * j + lane];
    for (int r = gw; r < TG; r += RP_NR * ngw) {
        f32x4 v[RP_NR][4]; int rr[RP_NR];
#pragma unroll
        for (int k = 0; k < RP_NR; ++k) { rr[k] = (r + k * ngw < TG) ? r + k * ngw : r; const f32x4* xr = (const f32x4*)(x + (size_t)rr[k] * DM) + lane;
#pragma unroll
            for (int j = 0; j < 4; ++j) v[k][j] = __builtin_nontemporal_load(xr + 64 * j); }
#pragma unroll
        for (int k = 0; k < RP_NR; ++k) { float s = 0.f;
#pragma unroll
            for (int j = 0; j < 4; ++j) s += ssq4(v[k][j]);
            const float rs = rsqrtf(wave_sum(s) * (1.0f / DM) + EPS); u32x2* o = (u32x2*)(HBF + (size_t)rr[k] * DM) + lane;
#pragma unroll
            for (int j = 0; j < 4; ++j) o[64 * j] = pk4(v[k][j] * rs * gv[j]); }
    }
}
__device__ __forceinline__ void rowpass1(const float* x, const bf16_t* MF, const float* ssq_m, const float* g1, bf16_t* X1, float* rs2, int gw, int ngw, int lane) {
    f32x4 g1v[4];
#pragma unroll
    for (int j = 0; j < 4; ++j) g1v[j] = ((const f32x4*)g1)[64 * j + lane];
    for (int r = gw; r < TG; r += RP_NR * ngw) {
        f32x4 v[RP_NR][4]; u32x2 wv[RP_NR][4]; int rr[RP_NR]; float rm[RP_NR];
#pragma unroll
        for (int k = 0; k < RP_NR; ++k) { rr[k] = (r + k * ngw < TG) ? r + k * ngw : r; const f32x4* xr = (const f32x4*)(x + (size_t)rr[k] * DM) + lane; const u32x2* mr = (const u32x2*)(MF + (size_t)rr[k] * DM) + lane;
            rm[k] = ssq_m[rr[k]];
#pragma unroll
            for (int j = 0; j < 4; ++j) { v[k][j] = __builtin_nontemporal_load(xr + 64 * j); wv[k][j] = __builtin_nontemporal_load(mr + 64 * j); } }
#pragma unroll
        for (int k = 0; k < RP_NR; ++k) { const float rmk = rsqrtf(rm[k] * (1.0f / DM) + EPS); float s = 0.f;
#pragma unroll
            for (int j = 0; j < 4; ++j) { v[k][j] = v[k][j] + unpk4(wv[k][j]) * rmk * g1v[j]; s += ssq4(v[k][j]); }
            const float rs = rsqrtf(wave_sum(s) * (1.0f / DM) + EPS);
            u32x2* orow = (u32x2*)(X1 + (size_t)rr[k] * DM) + lane; if (lane == 0) rs2[rr[k]] = rs * rs;
#pragma unroll
            for (int j = 0; j < 4; ++j) orow[64 * j] = pk4(v[k][j]); }
    }
}
__device__ __forceinline__ void rowpass2(const bf16_t* X1, const bf16_t* DF, const float* ssq_d, const float* g3, float* out, int gw, int ngw, int lane) {
    f32x4 g3v[4];
#pragma unroll
    for (int j = 0; j < 4; ++j) g3v[j] = ((const f32x4*)g3)[64 * j + lane];
    for (int r = gw; r < TG; r += RP_NR * ngw) {
        u32x2 xv[RP_NR][4]; u32x2 wv[RP_NR][4]; int rr[RP_NR]; float rd[RP_NR];
#pragma unroll
        for (int k = 0; k < RP_NR; ++k) { rr[k] = (r + k * ngw < TG) ? r + k * ngw : r; const u32x2* xr = (const u32x2*)(X1 + (size_t)rr[k] * DM) + lane; const u32x2* dr = (const u32x2*)(DF + (size_t)rr[k] * DM) + lane;
            rd[k] = ssq_d[rr[k]];
#pragma unroll
            for (int j = 0; j < 4; ++j) { xv[k][j] = __builtin_nontemporal_load(xr + 64 * j); wv[k][j] = __builtin_nontemporal_load(dr + 64 * j); } }
        asm volatile("" ::: "memory");
#pragma unroll
        for (int k = 0; k < RP_NR; ++k) { const float rdk = rsqrtf(rd[k] * (1.0f / DM) + EPS); f32x4* orow = (f32x4*)(out + (size_t)rr[k] * DM) + lane;
#pragma unroll
            for (int j = 0; j < 4; ++j) __builtin_nontemporal_store(unpk4(xv[k][j]) + unpk4(wv[k][j]) * rdk * g3v[j], orow + 64 * j); }
    }
}

#define LDS_BARRIER() asm volatile("s_waitcnt lgkmcnt(0)\n\ts_barrier" ::: "memory")
__device__ __forceinline__ void gload16_async(u32x4& r, const void* base, unsigned off) { r = *at<const u32x4>(base, off); }
#define VM_WAIT_N(n) asm volatile("s_waitcnt vmcnt(" #n ")" ::: "memory")
constexpr int AT_KP = 208, AT_VP = 144, AT_KB = 64 * AT_KP, AT_VB = 64 * AT_VP, AT_STAGE = AT_KB + AT_VB;
__device__ __forceinline__ void attn_phase(LAS unsigned char* lds, bf16_t* QN, bf16_t* OUT, const bf16_t* QR, const bf16_t* KN, const bf16_t* KR, const bf16_t* VT, int slog, int nseq, int vcu, int G) {
    int tid_ = threadIdx.x; asm volatile("" : "+v"(tid_));
    const int tid = tid_, w = __builtin_amdgcn_readfirstlane(tid >> 6), grp = w >> 2, lane = tid & 63, qi = lane & 31, hi = lane >> 5;
    const int S = 1 << slog, nqb = S >> 8, nunits = nseq * 8 * nqb, ntile = S >> 6;
    const int lk_row = tid >> 3, lk_c = tid & 7;
    const int lr_row = (tid & 255) >> 2, lr_c = tid & 3;
    const int lv_row = tid >> 3, lv_c = tid & 7;
    if (grp == 1) __builtin_amdgcn_s_setprio(1);
    for (int un = vcu; un < nunits; un += G) {
        const int qb = un % nqb, sh = un / nqb, h = sh & 7, seq = sh >> 3;
        const unsigned tokq = (unsigned)(seq * S + qb * 256 + w * 32 + qi);
        bf16x8 Qf[6];
#pragma unroll
        for (int s = 0; s < 4; ++s) Qf[s] = *at<const bf16x8>(QN, 2u * (tokq * 512u + (unsigned)(64 * h + 16 * s + 8 * hi)));
#pragma unroll
        for (int s = 0; s < 2; ++s) Qf[4 + s] = *at<const bf16x8>(QR, 2u * (tokq * 256u + (unsigned)(32 * h + 16 * s + 8 * hi)));
        f32x16 o0, o1, negm, p0, p1;
#pragma unroll
        for (int i = 0; i < 16; ++i) { o0[i] = 0.f; o1[i] = 0.f; negm[i] = 0.f; p0[i] = 0.f; p1[i] = 0.f; }
        float lsum = 0.f;
        const unsigned kn_off = 2u * (unsigned)((seq * S + lk_row) * 512 + 64 * h + 8 * lk_c);
        const unsigned kr_off = 2u * (unsigned)((seq * S + lr_row) * 32 + 8 * lr_c);
        const unsigned vt_off = 2u * (unsigned)(((seq * 8 + h) * 64 + lv_row) * S + 8 * lv_c);
        u32x4 rk = (u32x4){0u, 0u, 0u, 0u}, rr = rk, rv = rk, rk2 = rk, rr2 = rk, rv2 = rk;
        gload16_async(rk, KN, kn_off); gload16_async(rr, KR, kr_off); gload16_async(rv, VT, vt_off);
        VM_WAIT_N(0);
        LDS_BARRIER();
        *(LAS u32x4*)(lds + lk_row * AT_KP + 16 * lk_c) = rk;
        *(LAS u32x4*)(lds + AT_KB + lv_row * AT_VP + 16 * lv_c) = rv;
        if (tid < 256) *(LAS u32x4*)(lds + lr_row * AT_KP + 128 + 16 * lr_c) = rr;
        gload16_async(rk, KN, kn_off + 65536u); gload16_async(rr, KR, kr_off + 4096u); gload16_async(rv, VT, vt_off + 128u);
        gload16_async(rk2, KN, kn_off + 2u * 65536u); gload16_async(rr2, KR, kr_off + 2u * 4096u); gload16_async(rv2, VT, vt_off + 2u * 128u);
        LDS_BARRIER();
#define AT_H1(T) do { LAS unsigned char* Ks = lds + ((T) & 1) * AT_STAGE; \
            bf16x8 kf[6], kg[6]; \
            _Pragma("unroll") for (int s = 0; s < 3; ++s) { kf[2 * s] = *(const LAS bf16x8*)(Ks + qi * AT_KP + 32 * s + 16 * hi); kf[2 * s + 1] = *(const LAS bf16x8*)(Ks + (32 + qi) * AT_KP + 32 * s + 16 * hi); } \
            __builtin_amdgcn_sched_barrier(0); \
            _Pragma("unroll") for (int s = 3; s < 6; ++s) { kg[2 * (s - 3)] = *(const LAS bf16x8*)(Ks + qi * AT_KP + 32 * s + 16 * hi); kg[2 * (s - 3) + 1] = *(const LAS bf16x8*)(Ks + (32 + qi) * AT_KP + 32 * s + 16 * hi); } \
            p0 = __builtin_amdgcn_mfma_f32_32x32x16_bf16(kf[0], Qf[0], negm, 0, 0, 0); p1 = __builtin_amdgcn_mfma_f32_32x32x16_bf16(kf[1], Qf[0], negm, 0, 0, 0); \
            _Pragma("unroll") for (int s = 1; s < 3; ++s) { p0 = __builtin_amdgcn_mfma_f32_32x32x16_bf16(kf[2 * s], Qf[s], p0, 0, 0, 0); p1 = __builtin_amdgcn_mfma_f32_32x32x16_bf16(kf[2 * s + 1], Qf[s], p1, 0, 0, 0); } \
            __builtin_amdgcn_sched_barrier(0); \
            _Pragma("unroll") for (int s = 3; s < 6; ++s) { p0 = __builtin_amdgcn_mfma_f32_32x32x16_bf16(kg[2 * (s - 3)], Qf[s], p0, 0, 0, 0); p1 = __builtin_amdgcn_mfma_f32_32x32x16_bf16(kg[2 * (s - 3) + 1], Qf[s], p1, 0, 0, 0); } \
        } while (0)
#define AT_H2(T) do { const int t_ = (T); LAS unsigned char* Vs = lds + (t_ & 1) * AT_STAGE + AT_KB; \
            bf16x8 vf[4], vg[4]; \
            _Pragma("unroll") for (int s2 = 0; s2 < 2; ++s2) { vf[2 * s2] = *(const LAS bf16x8*)(Vs + qi * AT_VP + 32 * s2 + 16 * hi); vf[2 * s2 + 1] = *(const LAS bf16x8*)(Vs + (32 + qi) * AT_VP + 32 * s2 + 16 * hi); } \
            __builtin_amdgcn_sched_barrier(0); \
            float mxa = fmaxf(p0[0], p1[0]), mxb = fmaxf(p0[1], p1[1]), mxc = fmaxf(p0[2], p1[2]), mxd = fmaxf(p0[3], p1[3]); \
            _Pragma("unroll") for (int i = 4; i < 16; i += 4) { mxa = fmaxf(mxa, fmaxf(p0[i], p1[i])); mxb = fmaxf(mxb, fmaxf(p0[i + 1], p1[i + 1])); mxc = fmaxf(mxc, fmaxf(p0[i + 2], p1[i + 2])); mxd = fmaxf(mxd, fmaxf(p0[i + 3], p1[i + 3])); } \
            float mx = fmaxf(fmaxf(mxa, mxb), fmaxf(mxc, mxd)); \
            const bool resc = (t_ == 0) || (mx > 8.0f); \
            if (__builtin_amdgcn_ballot_w64(resc) != 0ull) { \
                mx = fmaxf(mx, __shfl_xor(mx, 32)); \
                const float d = (t_ == 0) ? mx : fmaxf(mx, 0.f); const float alpha = (t_ == 0) ? 1.0f : fast_exp2(-d); \
                lsum *= alpha; \
                _Pragma("unroll") for (int i = 0; i < 16; ++i) { o0[i] *= alpha; o1[i] *= alpha; p0[i] -= d; p1[i] -= d; negm[i] -= d; } \
            } \
            float rsa = 0.f, rsb = 0.f, rsc = 0.f, rsd = 0.f; \
            _Pragma("unroll") for (int i = 0; i < 16; i += 4) { \
                p0[i] = fast_exp2(p0[i]); p1[i] = fast_exp2(p1[i]); p0[i + 1] = fast_exp2(p0[i + 1]); p1[i + 1] = fast_exp2(p1[i + 1]); \
                p0[i + 2] = fast_exp2(p0[i + 2]); p1[i + 2] = fast_exp2(p1[i + 2]); p0[i + 3] = fast_exp2(p0[i + 3]); p1[i + 3] = fast_exp2(p1[i + 3]); \
                rsa += p0[i] + p1[i]; rsb += p0[i + 1] + p1[i + 1]; rsc += p0[i + 2] + p1[i + 2]; rsd += p0[i + 3] + p1[i + 3]; } \
            lsum += (rsa + rsb) + (rsc + rsd); \
            bf16x8 pf[2][2]; \
            _Pragma("unroll") for (int s2 = 0; s2 < 2; ++s2) { u32x4 a, b; \
                a.x = pg8::cvt_pk_bf16(p0[8 * s2 + 0], p0[8 * s2 + 1]); a.y = pg8::cvt_pk_bf16(p0[8 * s2 + 2], p0[8 * s2 + 3]); a.z = pg8::cvt_pk_bf16(p0[8 * s2 + 4], p0[8 * s2 + 5]); a.w = pg8::cvt_pk_bf16(p0[8 * s2 + 6], p0[8 * s2 + 7]); \
                b.x = pg8::cvt_pk_bf16(p1[8 * s2 + 0], p1[8 * s2 + 1]); b.y = pg8::cvt_pk_bf16(p1[8 * s2 + 2], p1[8 * s2 + 3]); b.z = pg8::cvt_pk_bf16(p1[8 * s2 + 4], p1[8 * s2 + 5]); b.w = pg8::cvt_pk_bf16(p1[8 * s2 + 6], p1[8 * s2 + 7]); \
                pf[0][s2] = __builtin_bit_cast(bf16x8, a); pf[1][s2] = __builtin_bit_cast(bf16x8, b); } \
            _Pragma("unroll") for (int s2 = 0; s2 < 2; ++s2) { vg[2 * s2] = *(const LAS bf16x8*)(Vs + qi * AT_VP + 64 + 32 * s2 + 16 * hi); vg[2 * s2 + 1] = *(const LAS bf16x8*)(Vs + (32 + qi) * AT_VP + 64 + 32 * s2 + 16 * hi); } \
            _Pragma("unroll") for (int s2 = 0; s2 < 2; ++s2) { o0 = __builtin_amdgcn_mfma_f32_32x32x16_bf16(vf[2 * s2], pf[0][s2], o0, 0, 0, 0); o1 = __builtin_amdgcn_mfma_f32_32x32x16_bf16(vf[2 * s2 + 1], pf[0][s2], o1, 0, 0, 0); } \
            __builtin_amdgcn_sched_barrier(0); \
            _Pragma("unroll") for (int s2 = 0; s2 < 2; ++s2) { o0 = __builtin_amdgcn_mfma_f32_32x32x16_bf16(vg[2 * s2], pf[1][s2], o0, 0, 0, 0); o1 = __builtin_amdgcn_mfma_f32_32x32x16_bf16(vg[2 * s2 + 1], pf[1][s2], o1, 0, 0, 0); } \
        } while (0)
#define AT_FEEDK(TN, RK, RR) do { const int tn_ = (TN); const unsigned tl_ = (unsigned)((tn_ + 2 < ntile) ? tn_ + 2 : ntile - 1); LAS unsigned char* Kn_ = lds + (tn_ & 1) * AT_STAGE; \
            *(LAS u32x4*)(Kn_ + lk_row * AT_KP + 16 * lk_c) = RK; \
            if (tid < 256) *(LAS u32x4*)(Kn_ + lr_row * AT_KP + 128 + 16 * lr_c) = RR; \
            gload16_async(RK, KN, kn_off + tl_ * 65536u); gload16_async(RR, KR, kr_off + tl_ * 4096u); \
            LDS_BARRIER(); } while (0)
#define AT_FEEDV(TN, RV) do { const int tn_ = (TN); const unsigned tl_ = (unsigned)((tn_ + 2 < ntile) ? tn_ + 2 : ntile - 1); LAS unsigned char* Kn_ = lds + (tn_ & 1) * AT_STAGE; \
            *(LAS u32x4*)(Kn_ + AT_KB + lv_row * AT_VP + 16 * lv_c) = RV; \
            gload16_async(RV, VT, vt_off + tl_ * 128u); \
            LDS_BARRIER(); } while (0)
        if (grp == 0) {
            for (int t = 0; t < ntile; t += 2) {
                AT_H1(t); AT_FEEDK(t + 1, rk, rr); AT_H2(t); AT_FEEDV(t + 1, rv);
                AT_H1(t + 1); AT_FEEDK(t + 2, rk2, rr2); AT_H2(t + 1); AT_FEEDV(t + 2, rv2);
            }
            AT_FEEDK(ntile + 1, rk, rr);
        } else {
            AT_FEEDK(1, rk, rr);
            for (int t = 0; t < ntile; t += 2) {
                AT_H1(t); AT_FEEDV(t + 1, rv); AT_H2(t); AT_FEEDK(t + 2, rk2, rr2);
                AT_H1(t + 1); AT_FEEDV(t + 2, rv2); AT_H2(t + 1); AT_FEEDK(t + 3, rk, rr);
            }
        }
#undef AT_FEEDK
#undef AT_FEEDV
#undef AT_H1
#undef AT_H2
        VM_WAIT_N(0);
        lsum += __shfl_xor(lsum, 32);
        const float inv = 1.0f / lsum;
        const unsigned op = 2u * (tokq * 512u + (unsigned)(64 * h + 4 * hi));
#pragma unroll
        for (int g4 = 0; g4 < 4; ++g4) {
            u32x2 a, b;
            a.x = pg8::cvt_pk_bf16(o0[4 * g4 + 0] * inv, o0[4 * g4 + 1] * inv); a.y = pg8::cvt_pk_bf16(o0[4 * g4 + 2] * inv, o0[4 * g4 + 3] * inv);
            b.x = pg8::cvt_pk_bf16(o1[4 * g4 + 0] * inv, o1[4 * g4 + 1] * inv); b.y = pg8::cvt_pk_bf16(o1[4 * g4 + 2] * inv, o1[4 * g4 + 3] * inv);
            *at<u32x2>(OUT, op + 16u * g4) = a; *at<u32x2>(OUT, op + 64u + 16u * g4) = b;
        }
    }
    __builtin_amdgcn_s_setprio(0);
    __syncthreads();
}

constexpr int RA_P = 288;
__device__ __forceinline__ void retA_phase(LAS unsigned char* lds, const bf16_t* RK, const bf16_t* RVT, bf16_t* ST, const float* ldf, const float* ldb, int slog, int nseq, int vcu, int G) {
    int tid_ = threadIdx.x; asm volatile("" : "+v"(tid_));
    const int tid = tid_, w = tid >> 6, lane = tid & 63, r16 = lane & 15, q = lane >> 4;
    const int S = 1 << slog, nch = S >> 7, nunits = nseq * 8 * nch;
    const int var = w >> 2, dvb = (w & 3) * 32;
    const int key = tid >> 2, d0 = (tid & 3) * 16;
#define RA_LOAD(UN) do { const int un_ = (UN); const int ch_ = un_ % nch, sh_ = un_ / nch, h_ = sh_ & 7, seq_ = sh_ >> 3; const size_t tokc_ = (size_t)seq_ * S + ch_ * 128; \
        pa = *(const u32x4*)(RK + (tokc_ + key) * 512 + 64 * h_ + d0); pb = *(const u32x4*)(RK + (tokc_ + key) * 512 + 64 * h_ + d0 + 8); \
        _Pragma("unroll") for (int b2 = 0; b2 < 2; ++b2) _Pragma("unroll") for (int ks = 0; ks < 4; ++ks) \
            pvf[b2][ks] = *(const bf16x8*)(RVT + ((size_t)(seq_ * 8 + h_) * 128 + dvb + 16 * b2 + r16) * S + ch_ * 128 + 32 * ks + 8 * q); } while (0)
    u32x4 pa, pb; bf16x8 pvf[2][4];
    if (vcu < nunits) RA_LOAD(vcu);
    for (int un = vcu; un < nunits; un += G) {
        const int ch = un % nch, sh = un / nch, h = sh & 7, seq = sh >> 3;
        const size_t tokc = (size_t)seq * S + ch * 128;
        const float lgf = ldf[h] * LOG2E, lgb = ldb[h] * LOG2E;
        bf16x8 vf[2][4];
        {
            const u32x4 a = pa, b = pb;
#pragma unroll
            for (int b2 = 0; b2 < 2; ++b2)
#pragma unroll
                for (int ks = 0; ks < 4; ++ks) vf[b2][ks] = pvf[b2][ks];
            const float sf = fast_exp2(lgf * (float)(127 - key)), sb = fast_exp2(lgb * (float)key);
            const int kp = (key & ~31) | (8 * ((key >> 2) & 3) + 4 * ((key >> 4) & 1) + (key & 3));
            const unsigned wv[8] = {a.x, a.y, a.z, a.w, b.x, b.y, b.z, b.w};
#pragma unroll
            for (int e = 0; e < 8; ++e) { const float x0 = bf_lo(wv[e]), x1 = bf_hi(wv[e]);
                *(LAS bf16_t*)(lds + (d0 + 2 * e) * RA_P + 2 * kp) = f2bf(x0 * sf); *(LAS bf16_t*)(lds + (d0 + 2 * e + 1) * RA_P + 2 * kp) = f2bf(x1 * sf);
                *(LAS bf16_t*)(lds + 64 * RA_P + (d0 + 2 * e) * RA_P + 2 * kp) = f2bf(x0 * sb); *(LAS bf16_t*)(lds + 64 * RA_P + (d0 + 2 * e + 1) * RA_P + 2 * kp) = f2bf(x1 * sb); }
        }
        __syncthreads();
        if (un + G < nunits) RA_LOAD(un + G);
        f32x4 acc[4][2];
#pragma unroll
        for (int db = 0; db < 4; ++db)
#pragma unroll
            for (int b2 = 0; b2 < 2; ++b2) acc[db][b2] = (f32x4){0.f, 0.f, 0.f, 0.f};
        const LAS unsigned char* Kx = lds + var * 64 * RA_P;
#pragma unroll
        for (int db = 0; db < 4; ++db)
#pragma unroll
            for (int ks = 0; ks < 4; ++ks) { const bf16x8 kf = *(const LAS bf16x8*)(Kx + (16 * db + r16) * RA_P + 64 * ks + 16 * q);
#pragma unroll
                for (int b2 = 0; b2 < 2; ++b2) acc[db][b2] = __builtin_amdgcn_mfma_f32_16x16x32_bf16(kf, vf[b2][ks], acc[db][b2], 0, 0, 0); }
        bf16_t* stp = ST + ((size_t)((tokc >> 7) * 8 + h) * 2 + var) * 8192;
#pragma unroll
        for (int db = 0; db < 4; ++db)
#pragma unroll
            for (int b2 = 0; b2 < 2; ++b2) { u32x2 wv2; wv2.x = pg8::cvt_pk_bf16(acc[db][b2][0], acc[db][b2][1]); wv2.y = pg8::cvt_pk_bf16(acc[db][b2][2], acc[db][b2][3]);
                *(u32x2*)(stp + (dvb + 16 * b2 + r16) * 64 + 16 * db + 4 * q) = wv2; }
        __syncthreads();
    }
#undef RA_LOAD
}
__device__ __forceinline__ void retB_phase(bf16_t* ST, const float* ldf, const float* ldb, int slog, int nseq, long gtid, long gthreads) {
    const int S = 1 << slog, nch = S >> 7; const long items = (long)nseq * 8 * 2 * 1024;
    for (long it = gtid; it < items; it += gthreads) {
        const int vec = (int)(it & 1023), var = (int)((it >> 10) & 1), h = (int)((it >> 11) & 7), seq = (int)(it >> 14);
        const float gam = fast_exp2((var ? ldb[h] : ldf[h]) * LOG2E * 128.0f);
        float run[8];
#pragma unroll
        for (int e = 0; e < 8; ++e) run[e] = 0.f;
        for (int n0 = 0; n0 < nch; n0 += 16) {
            u32x4 v[16]; bf16_t* p[16];
#pragma unroll
            for (int j = 0; j < 16; ++j) { const int n = var ? (nch - 1 - (n0 + j)) : (n0 + j); p[j] = ST + ((size_t)((seq * nch + n) * 8 + h) * 2 + var) * 8192 + vec * 8; v[j] = *(const u32x4*)p[j]; }
#pragma unroll
            for (int j = 0; j < 16; ++j) {
                u32x4 o; o.x = pg8::cvt_pk_bf16(run[0], run[1]); o.y = pg8::cvt_pk_bf16(run[2], run[3]); o.z = pg8::cvt_pk_bf16(run[4], run[5]); o.w = pg8::cvt_pk_bf16(run[6], run[7]);
                *(u32x4*)p[j] = o;
                run[0] = run[0] * gam + bf_lo(v[j].x); run[1] = run[1] * gam + bf_hi(v[j].x); run[2] = run[2] * gam + bf_lo(v[j].y); run[3] = run[3] * gam + bf_hi(v[j].y);
                run[4] = run[4] * gam + bf_lo(v[j].z); run[5] = run[5] * gam + bf_hi(v[j].z); run[6] = run[6] * gam + bf_lo(v[j].w); run[7] = run[7] * gam + bf_hi(v[j].w);
            }
        }
    }
}
constexpr int RC_KP = 160, RC_VP = 288, RC_SP = 160;
constexpr int RC_K = 0, RC_V = 128 * RC_KP, RC_SF = RC_V + 128 * RC_VP, RC_SB = RC_SF + 128 * RC_SP;
__device__ __forceinline__ void retC_phase(LAS unsigned char* lds, const bf16_t* RQ, const bf16_t* RK, const bf16_t* RVT, const bf16_t* ST, const bf16_t* SRG, bf16_t* OB,
                                           const float* ldf, const float* ldb, int slog, int nseq, int vcu, int G) {
    int tid_ = threadIdx.x; asm volatile("" : "+v"(tid_));
    const int tid = tid_, w = tid >> 6, lane = tid & 63, r16 = lane & 15, q = lane >> 4;
    const int S = 1 << slog, nch = S >> 7, nunits = nseq * 8 * nch;
#define RC_LOAD(UN) do { const int un_ = (UN); const int ch_ = un_ % nch, sh_ = un_ / nch, h_ = sh_ & 7, seq_ = sh_ >> 3; const size_t tokc_ = (size_t)seq_ * S + ch_ * 128; \
        _Pragma("unroll") for (int i = 0; i < 2; ++i) { const int id = tid + 512 * i, row = id >> 3, c = id & 7; pk[i] = *(const u32x4*)(RK + (tokc_ + row) * 512 + 64 * h_ + 8 * c); } \
        _Pragma("unroll") for (int i = 0; i < 4; ++i) { const int id = tid + 512 * i, row = id >> 4, c = id & 15; pv[i] = *(const u32x4*)(RVT + ((size_t)(seq_ * 8 + h_) * 128 + row) * S + ch_ * 128 + 8 * c); } \
        const bf16_t* stf_ = ST + ((size_t)((tokc_ >> 7) * 8 + h_) * 2) * 8192; \
        _Pragma("unroll") for (int i = 0; i < 2; ++i) { const int id = tid + 512 * i, row = id >> 3, c = id & 7; psf[i] = *(const u32x4*)(stf_ + row * 64 + 8 * c); psb[i] = *(const u32x4*)(stf_ + 8192 + row * 64 + 8 * c); } \
        _Pragma("unroll") for (int s_ = 0; s_ < 2; ++s_) pq[s_] = *(const bf16x8*)(RQ + (tokc_ + 16 * w + r16) * 512 + 64 * h_ + 32 * s_ + 8 * q); } while (0)
    u32x4 pk[2], pv[4], psf[2], psb[2]; bf16x8 pq[2];
    if (vcu < nunits) RC_LOAD(vcu);
    for (int un = vcu; un < nunits; un += G) {
        const int ch = un % nch, sh = un / nch, h = sh & 7, seq = sh >> 3;
        const size_t tokc = (size_t)seq * S + ch * 128;
        const float lgf = ldf[h] * LOG2E, lgb = ldb[h] * LOG2E;
#pragma unroll
        for (int i = 0; i < 2; ++i) { const int id = tid + 512 * i, row = id >> 3, c = id & 7; *(LAS u32x4*)(lds + RC_K + row * RC_KP + 16 * c) = pk[i]; }
#pragma unroll
        for (int i = 0; i < 4; ++i) { const int id = tid + 512 * i, row = id >> 4, c = id & 15; *(LAS u32x4*)(lds + RC_V + row * RC_VP + 16 * c) = pv[i]; }
#pragma unroll
        for (int i = 0; i < 2; ++i) { const int id = tid + 512 * i, row = id >> 3, c = id & 7;
            *(LAS u32x4*)(lds + RC_SF + row * RC_SP + 16 * c) = psf[i]; *(LAS u32x4*)(lds + RC_SB + row * RC_SP + 16 * c) = psb[i]; }
        bf16x8 Qf[2];
#pragma unroll
        for (int s = 0; s < 2; ++s) Qf[s] = pq[s];
        __syncthreads();
        u32x2 gqv[8];
#pragma unroll
        for (int dvb = 0; dvb < 8; ++dvb) gqv[dvb] = *(const u32x2*)(SRG + (tokc + 16 * w + r16) * 1024 + 128 * h + 16 * dvb + 4 * q);
        if (un + G < nunits) RC_LOAD(un + G);
        const int iq = 16 * w + r16; const size_t tok = tokc + iq;
        bf16x8 pf[4];
#pragma unroll
        for (int ks = 0; ks < 4; ++ks) {
            f32x4 sa[2];
#pragma unroll
            for (int hb = 0; hb < 2; ++hb) { const int kb = 2 * ks + hb; sa[hb] = (f32x4){0.f, 0.f, 0.f, 0.f};
#pragma unroll
                for (int s = 0; s < 2; ++s) { const bf16x8 kf = *(const LAS bf16x8*)(lds + RC_K + (16 * kb + r16) * RC_KP + 64 * s + 16 * q);
                    sa[hb] = __builtin_amdgcn_mfma_f32_16x16x32_bf16(kf, Qf[s], sa[hb], 0, 0, 0); }
#pragma unroll
                for (int i = 0; i < 4; ++i) { const int j = 16 * kb + 4 * q + i; const int df = iq - j; const float arg = (df >= 0) ? lgf * (float)df : lgb * (float)(-df); sa[hb][i] *= fast_exp2(arg); } }
            u32x4 pk; pk.x = pg8::cvt_pk_bf16(sa[0][0], sa[0][1]); pk.y = pg8::cvt_pk_bf16(sa[0][2], sa[0][3]); pk.z = pg8::cvt_pk_bf16(sa[1][0], sa[1][1]); pk.w = pg8::cvt_pk_bf16(sa[1][2], sa[1][3]);
            pf[ks] = __builtin_bit_cast(bf16x8, pk);
        }
        bf16x8 Qff[2], Qfb[2];
        { const float cf = fast_exp2(lgf * (float)(iq + 1)), cb = fast_exp2(lgb * (float)(128 - iq));
#pragma unroll
          for (int s = 0; s < 2; ++s) { const u32x4 qv = __builtin_bit_cast(u32x4, Qf[s]); const unsigned wv[4] = {qv.x, qv.y, qv.z, qv.w}; u32x4 a, b; unsigned ra[4], rb[4];
#pragma unroll
              for (int e = 0; e < 4; ++e) { const float x0 = bf_lo(wv[e]), x1 = bf_hi(wv[e]); ra[e] = pg8::cvt_pk_bf16(x0 * cf, x1 * cf); rb[e] = pg8::cvt_pk_bf16(x0 * cb, x1 * cb); }
              a.x = ra[0]; a.y = ra[1]; a.z = ra[2]; a.w = ra[3]; b.x = rb[0]; b.y = rb[1]; b.z = rb[2]; b.w = rb[3];
              Qff[s] = __builtin_bit_cast(bf16x8, a); Qfb[s] = __builtin_bit_cast(bf16x8, b); } }
        f32x4 oacc[8]; float ss = 0.f;
#pragma unroll
        for (int dvb = 0; dvb < 8; ++dvb) { f32x4 o = (f32x4){0.f, 0.f, 0.f, 0.f};
#pragma unroll
            for (int ks = 0; ks < 4; ++ks) { const bf16x8 vfr = *(const LAS bf16x8*)(lds + RC_V + (16 * dvb + r16) * RC_VP + 64 * ks + 16 * q);
                o = __builtin_amdgcn_mfma_f32_16x16x32_bf16(vfr, pf[ks], o, 0, 0, 0); }
#pragma unroll
            for (int s = 0; s < 2; ++s) { const bf16x8 sf = *(const LAS bf16x8*)(lds + RC_SF + (16 * dvb + r16) * RC_SP + 64 * s + 16 * q);
                const bf16x8 sb = *(const LAS bf16x8*)(lds + RC_SB + (16 * dvb + r16) * RC_SP + 64 * s + 16 * q);
                o = __builtin_amdgcn_mfma_f32_16x16x32_bf16(sf, Qff[s], o, 0, 0, 0);
                o = __builtin_amdgcn_mfma_f32_16x16x32_bf16(sb, Qfb[s], o, 0, 0, 0); }
            oacc[dvb] = o; ss += (o[0] * o[0] + o[1] * o[1]) + (o[2] * o[2] + o[3] * o[3]); }
        ss += __shfl_xor(ss, 16); ss += __shfl_xor(ss, 32);
        const float rstd = rsqrtf(ss * (1.0f / 128.0f) + EPS);
#pragma unroll
        for (int dvb = 0; dvb < 8; ++dvb) { const size_t off = tok * 1024 + 128 * h + 16 * dvb + 4 * q; const u32x2 gq = gqv[dvb];
            const f32x4 o = oacc[dvb]; u32x2 wv2; wv2.x = pg8::cvt_pk_bf16(o[0] * rstd * bf_lo(gq.x), o[1] * rstd * bf_hi(gq.x)); wv2.y = pg8::cvt_pk_bf16(o[2] * rstd * bf_lo(gq.y), o[3] * rstd * bf_hi(gq.y));
            *(u32x2*)(OB + off) = wv2; }
        __syncthreads();
    }
#undef RC_LOAD
}

#define XB_TMO      128
#define XB_XCNT(j)  (256  + 64 * (j))
#define XB_XSUB(j)  (1280 + 64 * (j))
#define XB_XGEN(j)  (2304 + 64 * (j))
#define XB_TOP      3328
#define XB_TOPGEN   3392
#define XCD_BAR_WORDS 3456
#define XB_SPIN_CAP (1u << 18)
__device__ __forceinline__ unsigned xb_ld(unsigned* p)              { return __hip_atomic_load(p, __ATOMIC_RELAXED, __HIP_MEMORY_SCOPE_AGENT); }
__device__ __forceinline__ unsigned xb_add(unsigned* p, unsigned v) { return __hip_atomic_fetch_add(p, v, __ATOMIC_RELAXED, __HIP_MEMORY_SCOPE_AGENT); }
__device__ __forceinline__ unsigned xb_xcc_id() { return (unsigned)__builtin_amdgcn_s_getreg((3 << 11) | 20) & 0xFu; }
#define XB_SPIN(cond, bar) do { unsigned _sp = 0; while (cond) { __builtin_amdgcn_s_sleep(1); \
    if ((++_sp & 255u) == 0u) { if (xb_ld(&(bar)[XB_TMO])) break; if (_sp > XB_SPIN_CAP) { atomicAdd(&(bar)[XB_TMO], 1u); break; } } } } while (0)
struct XcdBarrier { unsigned* bar; unsigned x; volatile LAS unsigned* st; };
__device__ __forceinline__ XcdBarrier xcd_barrier_post(unsigned* bar, volatile LAS unsigned* st) {
    XcdBarrier b; b.bar = bar; b.x = xb_xcc_id(); b.st = st;
    if (threadIdx.x == 0) (void)xb_add(&bar[XB_XCNT(b.x)], 1u);
    return b;
}
__device__ __forceinline__ void xcd_barrier_complete(unsigned* bar, unsigned x, unsigned& nloc, unsigned& nx) {
    const unsigned G = gridDim.x * gridDim.y * gridDim.z;
    unsigned sum, cnt, mine, sp = 0u;
    for (;;) {
        sum = 0u; cnt = 0u; mine = 0u;
#pragma unroll
        for (unsigned j = 0; j < 16; ++j) { const unsigned c = xb_ld(&bar[XB_XCNT(j)]); sum += c; cnt += (c > 0u) ? 1u : 0u; mine = (j == x) ? c : mine; }
        if (sum == G) break;
        __builtin_amdgcn_s_sleep(1);
        if ((++sp & 255u) == 0u) { if (xb_ld(&bar[XB_TMO])) break; if (sp > XB_SPIN_CAP) { atomicAdd(&bar[XB_TMO], 1u); break; } }
    }
    nloc = mine > 0u ? mine : 1u; nx = cnt > 0u ? cnt : 1u;
}
__device__ __forceinline__ void xcd_barrier(const XcdBarrier& b) {
    asm volatile("s_waitcnt vmcnt(0)" ::: "memory");
    __syncthreads();
    if (threadIdx.x == 0) {
        unsigned* bar = b.bar; asm volatile("" : "+s"(bar));
        __builtin_amdgcn_s_waitcnt(0);
        unsigned nloc = b.st[0], nx = b.st[1];
        if (nloc == 0u) { xcd_barrier_complete(bar, b.x, nloc, nx); b.st[0] = nloc; b.st[1] = nx; }
        const unsigned old = xb_add(&bar[XB_XSUB(b.x)], 1u);
        const unsigned gen = old / nloc;
        if (old + 1u == (gen + 1u) * nloc) {
            __builtin_amdgcn_fence(__ATOMIC_RELEASE, "agent");
            asm volatile("s_waitcnt vmcnt(0)" ::: "memory");
            const unsigned og = xb_add(&bar[XB_TOP], 1u);
            const unsigned tg = og / nx;
            if (og + 1u == (tg + 1u) * nx) xb_add(&bar[XB_TOPGEN], 1u);
            else XB_SPIN(xb_ld(&bar[XB_TOPGEN]) == tg, bar);
            __builtin_amdgcn_fence(__ATOMIC_ACQUIRE, "agent");
            xb_add(&bar[XB_XGEN(b.x)], 1u);
            asm volatile("s_waitcnt vmcnt(0)" ::: "memory");
        } else {
            XB_SPIN(xb_ld(&bar[XB_XGEN(b.x)]) == gen, bar);
            __builtin_amdgcn_fence(__ATOMIC_ACQUIRE, "agent");
            asm volatile("s_waitcnt vmcnt(0)" ::: "memory");
        }
    }
    __syncthreads();
}

#define WSP(off) (ws + (off))
#define SSQ ((float*)WSP(WS_SSQ))
#define W1A ((bf16_t*)WSP(WS_W1A))
#define W1B ((bf16_t*)WSP(WS_W1B))
#define WQ ((bf16_t*)WSP(WS_WQ))
#define WKV ((bf16_t*)WSP(WS_WKV))
#define WA ((bf16_t*)WSP(WS_WA))
#define WB ((bf16_t*)WSP(WS_WB))
#define WO ((bf16_t*)WSP(WS_WO))
#define WU ((bf16_t*)WSP(WS_WU))
#define WD ((bf16_t*)WSP(WS_WD))
#define HBF ((bf16_t*)WSP(A_HBF))
#define CQ ((bf16_t*)WSP(A_CQ))
#define CKV ((bf16_t*)WSP(A_CKV))
#define KR ((bf16_t*)WSP(A_KR))
#define RQ ((bf16_t*)WSP(A_RQ))
#define RK ((bf16_t*)WSP(A_RK))
#define RVT ((bf16_t*)WSP(A_RVT))
#define QN ((bf16_t*)WSP(A_QN))
#define QR ((bf16_t*)WSP(A_QR))
#define KN ((bf16_t*)WSP(A_KN))
#define VT ((bf16_t*)WSP(A_VT))
#define ST ((bf16_t*)WSP(A_ST))
#define G3 ((bf16_t*)WSP(A_G3))
#define SRG G3
#define SGA (G3 + (size_t)TG * 1024)
#define SGB (G3 + (size_t)2 * TG * 1024)
#define OB ((bf16_t*)WSP(A_OB))
#define MA ((bf16_t*)WSP(A_MA))
#define MG ((bf16_t*)WSP(A_MG))
#define MF ((bf16_t*)WSP(A_MF))
#define H2 ((bf16_t*)WSP(A_H2))
#define U ((bf16_t*)WSP(A_U))
#define DF ((bf16_t*)WSP(A_DF))
#define X1 ((bf16_t*)WSP(A_X1))
#define SSQP(g, k) (SSQ + (size_t)((g) * 4 + (k)) * TG)
#ifndef PHSEL
#define PHSEL -1
#endif
#define SEL(n) if constexpr (PHSEL < 0 || PHSEL == (n))
#define PHASE_BEGIN ArgsP ap = ap0; asm volatile("" : "+s"(ap)); unsigned char* ws = ap->ws; int tidp = threadIdx.x; asm volatile("" : "+v"(tidp)); \
    const int lane = tidp & 63, wave = tidp >> 6; const int vcu = (G % 8 == 0) ? (bx % 8) * (G / 8) + bx / 8 : bx; const long gtid = (long)bx * 512 + tidp, gthreads = (long)G * 512; const int gw = bx * 8 + wave, ngw = G * 8; \
    const float* xg = (g < 2) ? ap->x_prompt + (size_t)g * TG * DM : ap->x_sample; float* outg = ap->out + (size_t)g * TG * DM; \
    (void)lane; (void)vcu; (void)gtid; (void)gthreads; (void)gw; (void)ngw; (void)xg; (void)outg; (void)ws;

__global__ void __launch_bounds__(512, 2) fwd_megakernel(Args a_unused) {
    extern __shared__ __attribute__((aligned(16))) unsigned char lds_raw[];
    LAS unsigned char* lds = (LAS unsigned char*)lds_raw;
    cg::grid_group grid = cg::this_grid();
    typedef const __attribute__((address_space(4))) Args* ArgsP;
    ArgsP ap0 = (ArgsP)__builtin_amdgcn_kernarg_segment_ptr();
    const int G = gridDim.x, bx = blockIdx.x;
    volatile LAS unsigned* bst = (volatile LAS unsigned*)(lds + 131072 + 64);
    if (threadIdx.x < 2) bst[threadIdx.x] = 0u;
    __syncthreads();
    XcdBarrier xbar = xcd_barrier_post((unsigned*)(ap0->ws + WS_BAR), bst);
#define GSYNC() xcd_barrier(xbar)
    for (int g = 0; g < NGROUPS; ++g) {
        const int slog = (g < 2) ? 11 : 13, nseq = (g < 2) ? 16 : 4;

        if (g == 0) {
        { PHASE_BEGIN
            for (long i = gtid; i < (long)NGROUPS * 4 * TG; i += gthreads) SSQ[i] = 0.f;
            {
                constexpr int I0 = N1A * 16, I1 = N1B * 16, I2 = NQ * 4, I3 = NKV * 2, I4 = 1024 * 8, I5 = 1024 * 16, I6 = 1024 * 16, I7 = 4096 * 16, I8 = 1024 * 64;
                constexpr int ITOT = I0 + I1 + I2 + I3 + I4 + I5 + I6 + I7 + I8;
                for (int it = (int)gtid; it < ITOT; it += (int)gthreads) {
                    int r = it; CW c;
                    if (r < I0) c = CW{ap->w_in, 5536, 1024, N1A, 1, 0, nullptr, W1A};
                    else if ((r -= I0) < I1) c = CW{ap->w_in, 5536, 1024, N1B, 0, 2464, nullptr, W1B};
                    else if ((r -= I1) < I2) c = CW{ap->w_q_up, 768, 256, NQ, 2, 0, ap->g_q_norm, WQ};
                    else if ((r -= I2) < I3) c = CW{ap->w_kv_up, 1024, 128, NKV, 3, 0, ap->g_kv_norm, WKV};
                    else if ((r -= I3) < I4) c = CW{ap->w_branch_a, 1024, 512, 1024, 0, 0, nullptr, WA};
                    else if ((r -= I4) < I5) c = CW{ap->w_branch_b, 1024, 1024, 1024, 0, 0, nullptr, WB};
                    else if ((r -= I5) < I6) c = CW{ap->w_out, 1024, 1024, 1024, 0, 0, nullptr, WO};
                    else if ((r -= I6) < I7) c = CW{ap->w_up, 4096, 1024, 4096, 0, 0, ap->g_pre_mlp, WU};
                    else { r -= I7; c = CW{ap->w_down, 1024, 4096, 1024, 0, 0, nullptr, WD}; }
                    convert_item(c, r);
                }
            }
            rowpass0(xg, ap->g_pre_mix, HBF, gw, ngw, lane);
        }
        if (G == 0x7fffffff) grid.sync(); else GSYNC();
        }
        { PHASE_BEGIN
        SEL(1) { pg8::Gemm gm{HBF, W1A, TG, N1A, 1024}; pg8::StaticOrder S; S.init(TG, N1A, G, bx);
          Epi1 E{CQ, CKV, KR, RQ, RK, RVT, SSQP(g, 0), SSQP(g, 1), slog, lds + LDS_TSCR};
          pg8::gemm_phase<Epi1, pg8::StaticOrder, true, true>(lds, gm, S, E); }
        }
        GSYNC();
        { PHASE_BEGIN
        SEL(20) { pg8::Gemm gm{CQ, WQ, TG, NQ, 256}; pg8::StaticOrder S; S.init(TG, NQ, G, bx);
          Epi2q E{QN, QR, SSQP(g, 0), slog};
          pg8::gemm_phase<Epi2q, pg8::StaticOrder, true, true>(lds, gm, S, E); }
        SEL(21) { pg8::Gemm gm{CKV, WKV, TG, NKV, 128}; pg8::StaticOrder S; S.init(TG, NKV, G, bx);
          Epi2kv E{KN, VT, SSQP(g, 1), slog, lds + LDS_TSCR};
          pg8::gemm_phase<Epi2kv, pg8::StaticOrder, true, true>(lds, gm, S, E); }
        SEL(22) retA_phase(lds, RK, RVT, ST, ap->ldf, ap->ldb, slog, nseq, vcu, G);
#ifdef PROBE_RET2
        retA_phase(lds, RK, RVT, ST, ap->ldf, ap->ldb, slog, nseq, vcu, G);
#endif
        }
        GSYNC();
        { PHASE_BEGIN
        SEL(30) retB_phase(ST, ap->ldf, ap->ldb, slog, nseq, gtid, gthreads);
#ifdef PROBE_ATTN2
        attn_phase(lds, QN, OB, QR, KN, KR, VT, slog, nseq, vcu, G);
#endif
        SEL(31) attn_phase(lds, QN, QN, QR, KN, KR, VT, slog, nseq, vcu, G);
        SEL(32) { pg8::Gemm gm{HBF, W1B, TG, N1B, 1024}; pg8::StaticOrder S; S.init(TG, N1B, G, bx);
          EpiAct<1> E{G3, 1024, nullptr};
          pg8::gemm_phase<EpiAct<1>, pg8::StaticOrder, true, true>(lds, gm, S, E); }
        }
        GSYNC();
        { PHASE_BEGIN
        SEL(40) retC_phase(lds, RQ, RK, RVT, ST, SRG, OB, ap->ldf, ap->ldb, slog, nseq, vcu, G);
#ifdef PROBE_RET2
        retC_phase(lds, RQ, RK, RVT, ST, SRG, OB, ap->ldf, ap->ldb, slog, nseq, vcu, G);
#endif
        SEL(41) { pg8::Gemm gm{QN, WA, TG, 1024, 512}; pg8::StaticOrder S; S.init(TG, 1024, G, bx);
          Epi4 E{SGA, MA};
          pg8::gemm_phase<Epi4, pg8::StaticOrder, true, true>(lds, gm, S, E); }
        }
        GSYNC();
        { PHASE_BEGIN
        SEL(5) { pg8::Gemm gm{OB, WB, TG, 1024, 1024}; pg8::StaticOrder S; S.init(TG, 1024, G, bx);
          Epi5 E{SGB, MA, MG};
          pg8::gemm_phase<Epi5, pg8::StaticOrder, true, true>(lds, gm, S, E); }
        }
        GSYNC();
        { PHASE_BEGIN
        SEL(6) { pg8::Gemm gm{MG, WO, TG, 1024, 1024}; pg8::StaticOrder S; S.init(TG, 1024, G, bx);
          EpiF32Ssq E{MF, SSQP(g, 2)};
          pg8::gemm_phase<EpiF32Ssq, pg8::StaticOrder, true, true>(lds, gm, S, E); }
        }
        GSYNC();
        { PHASE_BEGIN
        SEL(7) rowpass1(xg, MF, SSQP(g, 2), ap->g_post_mix, X1, SSQP(g, 0), gw, ngw, lane);
        }
        GSYNC();
        { PHASE_BEGIN
        SEL(8) { pg8::Gemm gm{X1, WU, TG, DFF, 1024}; pg8::StaticOrder S; S.init(TG, DFF, G, bx);
          EpiAct<2> E{U, DFF, SSQP(g, 0)};
          pg8::gemm_phase<EpiAct<2>, pg8::StaticOrder, true, true>(lds, gm, S, E);
#ifdef PROBE_UP2
          pg8::gemm_phase<EpiAct<2>, pg8::StaticOrder, true, true>(lds, gm, S, E);
#endif
        }
        }
        GSYNC();
        { PHASE_BEGIN
        SEL(9) { pg8::Gemm gm{U, WD, TG, 1024, DFF}; pg8::StaticOrder S; S.init(TG, 1024, G, bx);
          EpiF32Ssq E{DF, SSQP(g, 3)};
          pg8::gemm_phase<EpiF32Ssq, pg8::StaticOrder, true, true>(lds, gm, S, E); }
        }
        GSYNC();
        { PHASE_BEGIN
        SEL(10) rowpass2(X1, DF, SSQP(g, 3), ap->g_post_mlp, outg, gw, ngw, lane);
        if (g + 1 < NGROUPS) { const float* xn = (g + 1 < 2) ? ap->x_prompt + (size_t)(g + 1) * TG * DM : ap->x_sample; rowpass0(xn, ap->g_pre_mix, HBF, gw, ngw, lane); }
        }
        if (g + 1 < NGROUPS) GSYNC();
#ifdef PROBE_SYNC
        for (int i_ = 0; i_ < 10; ++i_) GSYNC();
#endif
    }
}

extern "C" void kernel_launch(void* const* d_in, const int* in_sizes, int n_in, void* d_out, int out_size, void* d_ws, size_t ws_size, hipStream_t stream) {
    static int grid = 0;
    if (grid == 0) {
        if (n_in != 18 || ws_size < WS_NEED) { fprintf(stderr, "kernel_launch: unexpected n_in %d / ws %zu (need %zu)\n", n_in, ws_size, (size_t)WS_NEED); grid = -1; return; }
        int dev = 0, cus = 0, per_cu = 0;
        (void)hipGetDevice(&dev); (void)hipDeviceGetAttribute(&cus, hipDeviceAttributeMultiprocessorCount, dev);
        if (hipFuncSetAttribute((const void*)fwd_megakernel, hipFuncAttributeMaxDynamicSharedMemorySize, LDS_BYTES) != hipSuccess) { fprintf(stderr, "hipFuncSetAttribute failed\n"); grid = -1; return; }
        if (hipOccupancyMaxActiveBlocksPerMultiprocessor(&per_cu, (const void*)fwd_megakernel, 512, LDS_BYTES) != hipSuccess || per_cu < 1) { fprintf(stderr, "occupancy query: %d\n", per_cu); per_cu = 1; }
        (void)hipGetLastError();
        grid = cus;
    }
    if (grid < 0) return;
    Args a{};
    a.x_prompt = (const float*)d_in[0]; a.x_sample = (const float*)d_in[1]; a.g_pre_mix = (const float*)d_in[2]; a.w_in = (const float*)d_in[3];
    a.g_q_norm = (const float*)d_in[4]; a.w_q_up = (const float*)d_in[5]; a.g_kv_norm = (const float*)d_in[6]; a.w_kv_up = (const float*)d_in[7];
    a.w_branch_a = (const float*)d_in[8]; a.ldf = (const float*)d_in[9]; a.ldb = (const float*)d_in[10]; a.w_branch_b = (const float*)d_in[11];
    a.w_out = (const float*)d_in[12]; a.g_post_mix = (const float*)d_in[13]; a.g_pre_mlp = (const float*)d_in[14]; a.w_up = (const float*)d_in[15];
    a.w_down = (const float*)d_in[16]; a.g_post_mlp = (const float*)d_in[17];
    a.out = (float*)d_out; a.ws = (unsigned char*)d_ws;
    if (hipMemsetAsync((char*)d_ws + WS_BAR, 0, 16384, stream) != hipSuccess) { fprintf(stderr, "memset failed\n"); return; }
    void* args[] = {&a};
    hipError_t e = hipLaunchCooperativeKernel((const void*)fwd_megakernel, dim3(grid), dim3(512), args, LDS_BYTES, stream);
    if (e != hipSuccess) fprintf(stderr, "cooperative launch failed: %s (grid %d)\n", hipGetErrorString(e), grid);
}
```

```cpp
#include <hip/hip_runtime.h>
#include <hip/hip_cooperative_groups.h>
#include <cstdio>
#include <cstdint>
namespace cg = cooperative_groups;

#define LAS __attribute__((address_space(3)))
typedef unsigned short bf16_t;
typedef short bf16x8 __attribute__((ext_vector_type(8)));
typedef float f32x4 __attribute__((ext_vector_type(4)));
typedef float f32x16 __attribute__((ext_vector_type(16)));
typedef unsigned u32x4 __attribute__((ext_vector_type(4)));
typedef unsigned u32x2 __attribute__((ext_vector_type(2)));

namespace pg8 {
constexpr int BM = 256, BK = 64, HALF = 128, HTB = HALF * BK * 2, STAGE_BYTES = 8 * HTB, NXCD = 8, WGM = 8;
__host__ __device__ __forceinline__ int lds_byte(int r, int c) { const int st = (r >> 4) * 2 + (c >> 5), rr = r & 15, cc = c & 31, ob = rr * 64 + cc * 2; return st * 1024 + (ob ^ (((ob >> 9) & 1) << 5)); }
__host__ __device__ __forceinline__ void stage_rc(int b, int& R, int& C) { const int st = b / 1024, sb = b % 1024, swz = sb ^ (((sb >> 9) & 1) << 5); R = (st >> 1) * 16 + swz / 64; C = (st & 1) * 32 + (swz % 64) / 2; }
__host__ __device__ __forceinline__ int perm32(int rho) { const int n = rho >> 4, i = rho & 15; return 8 * (i >> 2) + 4 * n + (i & 3); }

struct Unit { int pm, pn; };
struct Gemm { const bf16_t* A; const bf16_t* Bt; int M, N, K; };

struct StaticOrder {
    int nM, nN, nwg, G, c, rev;
    __host__ __device__ void init(int M, int N, int G_, int c_, int rev_ = 0) { nM = M / BM; nN = N / BM; nwg = nM * nN; G = G_; c = c_; rev = rev_; }
    __host__ __device__ bool next(int i, Unit& u) const {
        const long L = (long)i * G + c; if (L >= nwg) return false;
        int wgid = (int)L; { const int q = nwg / NXCD, r = nwg % NXCD, xcd = wgid % NXCD, off = wgid / NXCD; wgid = (xcd < r ? xcd * (q + 1) : r * (q + 1) + (xcd - r) * q) + off; }
        const int nig = WGM * nN, gid = wgid / nig, fm = gid * WGM, gsz = (nM - fm) < WGM ? (nM - fm) : WGM;
        u.pm = fm + ((wgid % nig) % gsz); u.pn = (wgid % nig) / gsz; if (rev) u.pm = nM - 1 - u.pm; return true;
    }
    __device__ __forceinline__ void a_ready(const Unit&) const {}
    __device__ __forceinline__ void done(const Unit&) const {}
};

__device__ __forceinline__ unsigned cvt_pk_bf16(float lo, float hi) { unsigned r; asm volatile("v_cvt_pk_bf16_f32 %0, %1, %2" : "=v"(r) : "v"(lo), "v"(hi)); return r; }

template <class Epi, class Sched, bool ALIGN_EPI = false, bool SP2 = false>
__device__ __forceinline__ void gemm_phase(LAS unsigned char* lds, const Gemm g, const Sched& S, const Epi& E) {
    int tid_ = threadIdx.x; asm volatile("" : "+v"(tid_));
    const int tid = tid_, wid = __builtin_amdgcn_readfirstlane(tid >> 6), lane = tid & 63, wr = wid >> 2, wc = wid & 3, fr = lane & 15, fq = lane >> 4;
    int K_ = g.K; asm volatile("" : "+s"(K_));
    const int K = K_, nt = K / BK;
    unsigned voffA[2], voffB[2];
#pragma unroll
    for (int i = 0; i < 2; ++i) { int R, C; stage_rc(tid * 16 + i * 8192, R, C); const int Rb = Epi::PERM ? ((R & ~31) + perm32(R & 31)) : R;
        voffA[i] = (unsigned)(R * K + C) * 2u; voffB[i] = (unsigned)(Rb * K + C) * 2u; }
    const size_t kstep = (size_t)(BK * 2);
    const size_t hstep = (size_t)HALF * K * 2;
    const size_t tstep = 2 * hstep;
    const unsigned ldsw = (unsigned)wid * 1024u;
    const int aoff = lds_byte(wr * 64 + fr, fq * 8), boff = lds_byte(wc * 32 + fr, fq * 8);
#define PG8_SA(b, h) (((b) * 2 + (h)) * HTB)
#define PG8_SB(b, h) ((4 + (b) * 2 + (h)) * HTB)
#define PG8_STAGE(bufoff, gbase, voff) do { _Pragma("unroll") for (int _i = 0; _i < 2; ++_i) \
        __builtin_amdgcn_global_load_lds((const unsigned*)((const char*)(gbase) + (voff)[_i]), (LAS unsigned*)(lds + (bufoff) + ldsw + _i * 8192), 16, 0, 0); } while (0)
#define PG8_LDA(dst, b, h) do { _Pragma("unroll") for (int m = 0; m < 4; ++m) _Pragma("unroll") for (int k = 0; k < 2; ++k) dst[m][k] = *(const LAS bf16x8*)(lds + PG8_SA(b, h) + aoff + m * 2048 + k * 1024); } while (0)
#define PG8_LDB(dst, b, h) do { _Pragma("unroll") for (int n = 0; n < 2; ++n) _Pragma("unroll") for (int k = 0; k < 2; ++k) dst[n][k] = *(const LAS bf16x8*)(lds + PG8_SB(b, h) + boff + n * 2048 + k * 1024); } while (0)
#define PG8_MMA(ai, bj, At, Bt) do { __builtin_amdgcn_s_setprio(1); _Pragma("unroll") for (int m = 0; m < 4; ++m) _Pragma("unroll") for (int n = 0; n < 2; ++n) _Pragma("unroll") for (int k = 0; k < 2; ++k) \
        acc[ai][bj][m][n] = __builtin_amdgcn_mfma_f32_16x16x32_bf16(Bt[n][k], At[m][k], acc[ai][bj][m][n], 0, 0, 0); __builtin_amdgcn_s_setprio(0); } while (0)
#define PG8_WAIT_V(n) asm volatile("s_waitcnt vmcnt(" #n ")" ::: "memory")
#define PG8_WAIT_L(n) asm volatile("s_waitcnt lgkmcnt(" #n ")" ::: "memory")
#define PG8_BAR __builtin_amdgcn_s_barrier()
#define PG8_SCHED __builtin_amdgcn_sched_barrier(0)
    Unit cur, nxt; int ui = 0;
    if (!S.next(0, cur)) return;
    f32x4 acc[2][2][4][2];
#pragma unroll
    for (int a = 0; a < 2; ++a)
#pragma unroll
        for (int b = 0; b < 2; ++b)
#pragma unroll
            for (int m = 0; m < 4; ++m)
#pragma unroll
                for (int n = 0; n < 2; ++n) acc[a][b][m][n] = (f32x4){0.f, 0.f, 0.f, 0.f};
    bf16x8 At[4][2], B0[2][2], B1[2][2];
    const char* cA = (const char*)g.A + (size_t)cur.pm * tstep; const char* cB = (const char*)g.Bt + (size_t)cur.pn * tstep;
    S.a_ready(cur);
    if constexpr (SP2) {
        PG8_STAGE(PG8_SB(0, 0), cB, voffB); PG8_STAGE(PG8_SB(0, 1), cB + hstep, voffB); PG8_STAGE(PG8_SA(0, 0), cA, voffA); PG8_STAGE(PG8_SA(0, 1), cA + hstep, voffA);
        if (wr == 1) PG8_BAR;
        PG8_WAIT_V(2); PG8_BAR;
        PG8_STAGE(PG8_SB(1, 0), cB + kstep, voffB); PG8_STAGE(PG8_SA(1, 0), cA + kstep, voffA); PG8_STAGE(PG8_SB(1, 1), cB + hstep + kstep, voffB);
        PG8_WAIT_V(6); PG8_BAR;
    } else {
        PG8_STAGE(PG8_SB(0, 0), cB, voffB); PG8_STAGE(PG8_SA(0, 0), cA, voffA); PG8_STAGE(PG8_SB(0, 1), cB + hstep, voffB); PG8_STAGE(PG8_SA(0, 1), cA + hstep, voffA);
        if (wr == 1) PG8_BAR;
        PG8_WAIT_V(4); PG8_BAR;
        PG8_STAGE(PG8_SB(1, 0), cB + kstep, voffB); PG8_STAGE(PG8_SA(1, 0), cA + kstep, voffA); PG8_STAGE(PG8_SB(1, 1), cB + hstep + kstep, voffB);
        PG8_WAIT_V(6); PG8_BAR;
    }
    for (;;) {
        const bool has_next = S.next(ui + 1, nxt);
        const char* nA = has_next ? (const char*)g.A + (size_t)nxt.pm * tstep : cA; const char* nB = has_next ? (const char*)g.Bt + (size_t)nxt.pn * tstep : cB;
        for (int t = 0; t < nt; t += 2) {
            const bool last = (t == nt - 2);
            const char* a1 = cA + (size_t)(t + 1) * kstep;
            const char* a2 = last ? nA : cA + (size_t)(t + 2) * kstep; const char* b2 = last ? nB : cB + (size_t)(t + 2) * kstep;
            const char* a3 = a2 + kstep; const char* b3 = b2 + kstep;
            if (last && has_next) S.a_ready(nxt);
            if constexpr (SP2) {
            PG8_LDB(B0, 0, 0); PG8_LDB(B1, 0, 1); PG8_SCHED; PG8_LDA(At, 0, 0); PG8_STAGE(PG8_SA(1, 1), a1 + hstep, voffA);
            PG8_WAIT_V(8); PG8_WAIT_L(0); PG8_BAR; PG8_MMA(0, 0, At, B0); PG8_MMA(0, 1, At, B1); PG8_BAR; PG8_SCHED;
            PG8_LDA(At, 0, 1); PG8_STAGE(PG8_SB(0, 0), b2, voffB); PG8_STAGE(PG8_SB(0, 1), b2 + hstep, voffB); PG8_STAGE(PG8_SA(0, 0), a2, voffA);
            PG8_WAIT_V(8); PG8_WAIT_L(0); PG8_BAR; PG8_MMA(1, 0, At, B0); PG8_MMA(1, 1, At, B1); PG8_BAR; PG8_SCHED;
            PG8_LDB(B0, 1, 0); PG8_LDB(B1, 1, 1); PG8_SCHED; PG8_LDA(At, 1, 0); PG8_STAGE(PG8_SA(0, 1), a2 + hstep, voffA);
            PG8_WAIT_V(8); PG8_WAIT_L(0); PG8_BAR; PG8_MMA(0, 0, At, B0); PG8_MMA(0, 1, At, B1); PG8_BAR; PG8_SCHED;
            PG8_LDA(At, 1, 1); PG8_STAGE(PG8_SB(1, 0), b3, voffB); PG8_STAGE(PG8_SB(1, 1), b3 + hstep, voffB); PG8_STAGE(PG8_SA(1, 0), a3, voffA);
            PG8_WAIT_V(8); PG8_WAIT_L(0); PG8_BAR; PG8_MMA(1, 0, At, B0); PG8_MMA(1, 1, At, B1); PG8_BAR; PG8_SCHED;
            } else {
            PG8_LDB(B0, 0, 0); PG8_SCHED; PG8_LDA(At, 0, 0); PG8_STAGE(PG8_SA(1, 1), a1 + hstep, voffA);
            PG8_WAIT_L(8); PG8_BAR; PG8_WAIT_L(0); PG8_MMA(0, 0, At, B0); PG8_BAR; PG8_SCHED;
            PG8_LDB(B1, 0, 1); PG8_STAGE(PG8_SB(0, 0), b2, voffB);
            PG8_BAR; PG8_WAIT_L(0); PG8_MMA(0, 1, At, B1); PG8_BAR;
            PG8_LDA(At, 0, 1); PG8_STAGE(PG8_SA(0, 0), a2, voffA);
            PG8_BAR; PG8_WAIT_L(0); PG8_MMA(1, 0, At, B0); PG8_BAR; PG8_SCHED;
            PG8_STAGE(PG8_SB(0, 1), b2 + hstep, voffB);
            PG8_WAIT_V(6); PG8_BAR; PG8_MMA(1, 1, At, B1); PG8_BAR;
            PG8_LDB(B0, 1, 0); PG8_SCHED; PG8_LDA(At, 1, 0); PG8_STAGE(PG8_SA(0, 1), a2 + hstep, voffA);
            PG8_WAIT_L(8); PG8_BAR; PG8_WAIT_L(0); PG8_MMA(0, 0, At, B0); PG8_BAR; PG8_SCHED;
            PG8_LDB(B1, 1, 1); PG8_STAGE(PG8_SB(1, 0), b3, voffB);
            PG8_BAR; PG8_WAIT_L(0); PG8_MMA(0, 1, At, B1); PG8_BAR;
            PG8_LDA(At, 1, 1); PG8_STAGE(PG8_SA(1, 0), a3, voffA);
            PG8_BAR; PG8_WAIT_L(0); PG8_MMA(1, 0, At, B0); PG8_BAR; PG8_SCHED;
            PG8_STAGE(PG8_SB(1, 1), b3 + hstep, voffB);
            PG8_WAIT_V(6); PG8_BAR; PG8_MMA(1, 1, At, B1); PG8_BAR;
            }
        }
        if constexpr (ALIGN_EPI) { if (wr == 0) PG8_BAR; }
        E(acc, cur, wr, wc, fr, fq);
        if (!has_next) break;
#pragma unroll
        for (int a = 0; a < 2; ++a)
#pragma unroll
            for (int b = 0; b < 2; ++b)
#pragma unroll
                for (int m = 0; m < 4; ++m)
#pragma unroll
                    for (int n = 0; n < 2; ++n) acc[a][b][m][n] = (f32x4){0.f, 0.f, 0.f, 0.f};
        cur = nxt; cA = nA; cB = nB; ++ui;
        if constexpr (ALIGN_EPI) { if (wr == 1) PG8_BAR; }
    }
    PG8_WAIT_V(0);
    if constexpr (!ALIGN_EPI) { if (wr == 0) PG8_BAR; }
    PG8_BAR;
#undef PG8_SA
#undef PG8_SB
#undef PG8_STAGE
#undef PG8_LDA
#undef PG8_LDB
#undef PG8_MMA
#undef PG8_WAIT_V
#undef PG8_WAIT_L
#undef PG8_BAR
#undef PG8_SCHED
}
}

constexpr int DM = 1024, TG = 32768, NGROUPS = 3, DFF = 4096;
constexpr int N1A = 2560, N1B = 3072, NQ = 768, NKV = 1024;
constexpr float EPS = 1e-6f;
constexpr float LOG2E = 1.4426950408889634f;
constexpr float QSCALE = 0.10206207261596575f * LOG2E;
constexpr float LOG2_THETA = 13.287712379549449f;
constexpr float INV_2PI = 0.15915494309189535f;

constexpr size_t MiB = 1u << 20;
constexpr size_t WS_SSQ = 0;
constexpr size_t WS_BAR = 1792 * 1024;
constexpr size_t WS_W1A = 2 * MiB;
constexpr size_t WS_W1B = 7 * MiB;
constexpr size_t WS_WQ = 13 * MiB;
constexpr size_t WS_WKV = 13 * MiB + 512 * 1024;
constexpr size_t WS_WA = 14 * MiB;
constexpr size_t WS_WB = 15 * MiB;
constexpr size_t WS_WO = 17 * MiB;
constexpr size_t WS_WU = 19 * MiB;
constexpr size_t WS_WD = 27 * MiB;
constexpr size_t WS_ACT = 40 * MiB;
constexpr size_t A_HBF = WS_ACT + 0 * MiB, A_CQ = WS_ACT + 64 * MiB, A_CKV = WS_ACT + 80 * MiB, A_KR = WS_ACT + 88 * MiB;
constexpr size_t A_RQ = WS_ACT + 96 * MiB, A_RK = WS_ACT + 128 * MiB, A_RVT = WS_ACT + 160 * MiB, A_QN = WS_ACT + 224 * MiB;
constexpr size_t A_QR = WS_ACT + 256 * MiB, A_KN = WS_ACT + 272 * MiB, A_VT = WS_ACT + 304 * MiB, A_ST = WS_ACT + 336 * MiB;
constexpr size_t A_G3 = WS_ACT + 400 * MiB;
constexpr size_t A_OB = WS_ACT + 592 * MiB, A_MA = WS_ACT + 656 * MiB, A_MG = WS_ACT + 784 * MiB;
constexpr size_t A_MF = WS_ACT + 0 * MiB, A_H2 = WS_ACT + 128 * MiB, A_U = WS_ACT + 192 * MiB, A_DF = WS_ACT + 448 * MiB;
constexpr size_t A_X1 = WS_ACT + 512 * MiB;
constexpr size_t WS_NEED = WS_ACT + 848 * MiB;

constexpr int LDS_BYTES = 155648;
constexpr int LDS_TSCR = 131328, TS_P = 80;

__device__ __forceinline__ float bf_lo(unsigned u) { return __uint_as_float(u << 16); }
__device__ __forceinline__ float bf_hi(unsigned u) { return __uint_as_float(u & 0xffff0000u); }
__device__ __forceinline__ bf16_t f2bf(float f) { return (bf16_t)(pg8::cvt_pk_bf16(f, f) & 0xffffu); }
__device__ __forceinline__ float wave_sum(float v) {
#pragma unroll
    for (int o = 1; o < 64; o <<= 1) v += __shfl_xor(v, o);
    return v;
}
__device__ __forceinline__ float fast_exp2(float x) { return __builtin_amdgcn_exp2f(x); }
__device__ __forceinline__ float sigmoidf_(float v) { return __builtin_amdgcn_rcpf(1.0f + fast_exp2(-v * LOG2E)); }
__device__ __forceinline__ void sincos_rev(float pos, float invf, float& s, float& c) {
    const float ang = pos * invf; const float fr = __builtin_amdgcn_fractf(ang * INV_2PI);
    s = __builtin_amdgcn_sinf(fr); c = __builtin_amdgcn_cosf(fr);
}
__device__ __forceinline__ void atomic_addf(float* p, float v) { __hip_atomic_fetch_add(p, v, __ATOMIC_RELAXED, __HIP_MEMORY_SCOPE_AGENT); }
__device__ __forceinline__ u32x4 pack8(const f32x4& a, const f32x4& b) {
    u32x4 w; w.x = pg8::cvt_pk_bf16(a[0], a[1]); w.y = pg8::cvt_pk_bf16(a[2], a[3]); w.z = pg8::cvt_pk_bf16(b[0], b[1]); w.w = pg8::cvt_pk_bf16(b[2], b[3]); return w;
}

typedef f32x4 AccT[2][2][4][2];
template <class T> __device__ __forceinline__ T* at(const void* base, unsigned byteoff) { return (T*)((char*)base + byteoff); }

struct Epi1 {
    static constexpr bool PERM = true;
    bf16_t *CQ, *CKV, *KR, *RQ, *RK, *RVT; float *ssq_q, *ssq_kv; int slog; LAS unsigned char* tscr;
    __device__ __forceinline__ void operator()(const AccT& acc, const pg8::Unit& u, int wr, int wc, int fr, int fq) const {
        asm volatile("" : "+v"(fr), "+v"(fq), "+s"(wr), "+s"(wc));
        const int pn = u.pn, S = 1 << slog; const int rowb = u.pm * 256 + wr * 64 + fr;
        if (pn == 0) {
#pragma unroll
            for (int ai = 0; ai < 2; ++ai)
#pragma unroll
                for (int m = 0; m < 4; ++m) { const int row = rowb + ai * 128 + m * 16; float s = 0.f;
#pragma unroll
                    for (int bj = 0; bj < 2; ++bj) { const f32x4 v0 = acc[ai][bj][m][0], v1 = acc[ai][bj][m][1];
                        s += (v0[0] * v0[0] + v0[1] * v0[1]) + (v0[2] * v0[2] + v0[3] * v0[3]) + (v1[0] * v1[0] + v1[1] * v1[1]) + (v1[2] * v1[2] + v1[3] * v1[3]);
                        *at<u32x4>(CQ, 2u * (unsigned)(row * 256 + bj * 128 + wc * 32 + 8 * fq)) = pack8(v0, v1); }
                    s += __shfl_xor(s, 16); s += __shfl_xor(s, 32);
                    if (fq == 0) atomic_addf(at<float>(ssq_q, 4u * (unsigned)row), s); }
        } else if (pn == 1) {
            float invf[4];
#pragma unroll
            for (int j = 0; j < 4; ++j) invf[j] = fast_exp2(-(float)(4 * fq + j) * (LOG2_THETA / 16.0f));
#pragma unroll
            for (int ai = 0; ai < 2; ++ai)
#pragma unroll
                for (int m = 0; m < 4; ++m) { const int row = rowb + ai * 128 + m * 16;
                    { const f32x4 v0 = acc[ai][0][m][0], v1 = acc[ai][0][m][1];
                      float s = (v0[0] * v0[0] + v0[1] * v0[1]) + (v0[2] * v0[2] + v0[3] * v0[3]) + (v1[0] * v1[0] + v1[1] * v1[1]) + (v1[2] * v1[2] + v1[3] * v1[3]);
                      *at<u32x4>(CKV, 2u * (unsigned)(row * 128 + wc * 32 + 8 * fq)) = pack8(v0, v1);
                      s += __shfl_xor(s, 16); s += __shfl_xor(s, 32);
                      if (fq == 0) atomic_addf(at<float>(ssq_kv, 4u * (unsigned)row), s); }
                    if (wc == 0) { const f32x4 x1 = acc[ai][1][m][0], x2 = acc[ai][1][m][1]; const float pos = (float)(row & (S - 1)); f32x4 o1, o2;
#pragma unroll
                        for (int j = 0; j < 4; ++j) { float sn, cs; sincos_rev(pos, invf[j], sn, cs); o1[j] = x1[j] * cs - x2[j] * sn; o2[j] = x1[j] * sn + x2[j] * cs; }
                        *at<u32x4>(KR, 2u * (unsigned)(row * 32 + 8 * fq)) = pack8(o1, o2); } }
        } else if (pn <= 5) {
            const bool isk = pn >= 4; bf16_t* dst = isk ? RK : RQ; const float sc = isk ? 0.125f : 1.0f; const int colt = (pn & 1) * 256;
            const int g = (wc & 1) * 4 + fq; float invf[4];
#pragma unroll
            for (int j = 0; j < 4; ++j) invf[j] = fast_exp2(-(float)(4 * g + j) * (LOG2_THETA / 32.0f));
#pragma unroll
            for (int ai = 0; ai < 2; ++ai)
#pragma unroll
                for (int m = 0; m < 4; ++m) { const int row = rowb + ai * 128 + m * 16; const float pos = (float)(row & (S - 1)); float sn[4], cs[4];
#pragma unroll
                    for (int j = 0; j < 4; ++j) sincos_rev(pos, invf[j], sn[j], cs[j]);
#pragma unroll
                    for (int bj = 0; bj < 2; ++bj) { const f32x4 x1 = acc[ai][bj][m][0], x2 = acc[ai][bj][m][1]; f32x4 o1, o2;
#pragma unroll
                        for (int j = 0; j < 4; ++j) { o1[j] = (x1[j] * cs[j] - x2[j] * sn[j]) * sc; o2[j] = (x1[j] * sn[j] + x2[j] * cs[j]) * sc; }
                        *at<u32x4>(dst, 2u * (unsigned)(row * 512 + colt + bj * 128 + wc * 32 + 8 * fq)) = pack8(o1, o2); } }
        } else {
            LAS unsigned char* tl = tscr + (wr * 4 + wc) * (32 * TS_P); const int lane = fq * 16 + fr, rdv = lane >> 1, rh = lane & 1;
#pragma unroll
            for (int ai = 0; ai < 2; ++ai)
#pragma unroll
                for (int mp = 0; mp < 2; ++mp)
#pragma unroll
                    for (int bj = 0; bj < 2; ++bj) {
#pragma unroll
                        for (int mm = 0; mm < 2; ++mm) { const int p = 8 * (fr >> 2) + 4 * mm + (fr & 3);
#pragma unroll
                            for (int n = 0; n < 2; ++n)
#pragma unroll
                                for (int j = 0; j < 4; ++j) *(LAS bf16_t*)(tl + (8 * fq + 4 * n + j) * TS_P + 2 * p) = f2bf(acc[ai][bj][2 * mp + mm][n][j]); }
                        const u32x4 q0 = *(const LAS u32x4*)(tl + rdv * TS_P + 32 * rh), q1 = *(const LAS u32x4*)(tl + rdv * TS_P + 32 * rh + 16);
                        const int tokb = u.pm * 256 + ai * 128 + wr * 64 + 32 * mp; const int seq = tokb >> slog, posb = tokb & (S - 1);
                        const int colb = (pn - 6) * 256 + bj * 128 + wc * 32; const int head = colb >> 7, dvh = colb & 127;
                        const unsigned gb = 2u * (unsigned)(((seq * 8 + head) * 128 + dvh + rdv) * S + posb + 16 * rh);
                        *at<u32x4>(RVT, gb) = q0; *at<u32x4>(RVT, gb + 16u) = q1; }
        }
    }
};

struct Epi2q {
    static constexpr bool PERM = true;
    bf16_t *QN, *QR; const float* ssq_q; int slog;
    __device__ __forceinline__ void operator()(const AccT& acc, const pg8::Unit& u, int wr, int wc, int fr, int fq) const {
        asm volatile("" : "+v"(fr), "+v"(fq), "+s"(wr), "+s"(wc));
        const int pn = u.pn, S = 1 << slog; const int rowb = u.pm * 256 + wr * 64 + fr;
        float invf[4];
#pragma unroll
        for (int j = 0; j < 4; ++j) invf[j] = fast_exp2(-(float)(4 * fq + j) * (LOG2_THETA / 16.0f));
#pragma unroll
        for (int ai = 0; ai < 2; ++ai)
#pragma unroll
            for (int m = 0; m < 4; ++m) { const int row = rowb + ai * 128 + m * 16; const float f = rsqrtf(*at<const float>(ssq_q, 4u * (unsigned)row) * (1.0f / 256.0f) + EPS) * QSCALE;
                if (pn < 2) {
#pragma unroll
                    for (int bj = 0; bj < 2; ++bj) *at<u32x4>(QN, 2u * (unsigned)(row * 512 + pn * 256 + bj * 128 + wc * 32 + 8 * fq)) = pack8(acc[ai][bj][m][0] * f, acc[ai][bj][m][1] * f);
                } else { const float pos = (float)(row & (S - 1)); float sn[4], cs[4];
#pragma unroll
                    for (int j = 0; j < 4; ++j) sincos_rev(pos, invf[j], sn[j], cs[j]);
#pragma unroll
                    for (int bj = 0; bj < 2; ++bj) { const f32x4 x1 = acc[ai][bj][m][0], x2 = acc[ai][bj][m][1]; f32x4 o1, o2;
#pragma unroll
                        for (int j = 0; j < 4; ++j) { o1[j] = (x1[j] * cs[j] - x2[j] * sn[j]) * f; o2[j] = (x1[j] * sn[j] + x2[j] * cs[j]) * f; }
                        *at<u32x4>(QR, 2u * (unsigned)(row * 256 + bj * 128 + wc * 32 + 8 * fq)) = pack8(o1, o2); } } }
    }
};

struct Epi2kv {
    static constexpr bool PERM = true;
    bf16_t *KN, *VT; const float* ssq_kv; int slog; LAS unsigned char* tscr;
    __device__ __forceinline__ void operator()(const AccT& acc, const pg8::Unit& u, int wr, int wc, int fr, int fq) const {
        asm volatile("" : "+v"(fr), "+v"(fq), "+s"(wr), "+s"(wc));
        const int pn = u.pn, S = 1 << slog; const int rowb = u.pm * 256 + wr * 64 + fr;
        if (pn < 2) {
#pragma unroll
            for (int ai = 0; ai < 2; ++ai)
#pragma unroll
                for (int m = 0; m < 4; ++m) { const int row = rowb + ai * 128 + m * 16; const float f = rsqrtf(*at<const float>(ssq_kv, 4u * (unsigned)row) * (1.0f / 128.0f) + EPS);
#pragma unroll
                    for (int bj = 0; bj < 2; ++bj) *at<u32x4>(KN, 2u * (unsigned)(row * 512 + pn * 256 + bj * 128 + wc * 32 + 8 * fq)) = pack8(acc[ai][bj][m][0] * f, acc[ai][bj][m][1] * f); }
        } else {
            LAS unsigned char* tl = tscr + (wr * 4 + wc) * (32 * TS_P); const int lane = fq * 16 + fr, rdv = lane >> 1, rh = lane & 1;
            const int p16 = 8 * ((fr >> 2) & 1) + 4 * (fr >> 3) + (fr & 3);
#pragma unroll
            for (int ai = 0; ai < 2; ++ai)
#pragma unroll
                for (int mp = 0; mp < 2; ++mp) {
                    float f[2];
#pragma unroll
                    for (int mm = 0; mm < 2; ++mm) f[mm] = rsqrtf(*at<const float>(ssq_kv, 4u * (unsigned)(rowb + ai * 128 + (2 * mp + mm) * 16)) * (1.0f / 128.0f) + EPS);
#pragma unroll
                    for (int bj = 0; bj < 2; ++bj) {
#pragma unroll
                        for (int mm = 0; mm < 2; ++mm) { const int p = 16 * mm + p16;
#pragma unroll
                            for (int n = 0; n < 2; ++n)
#pragma unroll
                                for (int j = 0; j < 4; ++j) *(LAS bf16_t*)(tl + (8 * fq + 4 * n + j) * TS_P + 2 * p) = f2bf(acc[ai][bj][2 * mp + mm][n][j] * f[mm]); }
                        const u32x4 q0 = *(const LAS u32x4*)(tl + rdv * TS_P + 32 * rh), q1 = *(const LAS u32x4*)(tl + rdv * TS_P + 32 * rh + 16);
                        const int tokb = u.pm * 256 + ai * 128 + wr * 64 + 32 * mp; const int seq = tokb >> slog, posb = tokb & (S - 1);
                        const int colb = (pn - 2) * 256 + bj * 128 + wc * 32; const int head = colb >> 6, dvh = colb & 63;
                        const unsigned gb = 2u * (unsigned)(((seq * 8 + head) * 64 + dvh + rdv) * S + posb + 16 * rh);
                        *at<u32x4>(VT, gb) = q0; *at<u32x4>(VT, gb + 16u) = q1; } }
        }
    }
};

template <int ACT> struct EpiAct {
    static constexpr bool PERM = true;
    bf16_t* O; int ldc; const float* rs2;
    __device__ __forceinline__ void operator()(const AccT& acc, const pg8::Unit& u, int wr, int wc, int fr, int fq) const {
        asm volatile("" : "+v"(fr), "+v"(fq), "+s"(wr), "+s"(wc));
        const int rowb = u.pm * 256 + wr * 64 + fr; int colt = u.pn * 256; unsigned boff = 0u; bool silu = false;
        if (ACT == 1) { const int t = u.pn >> 2; boff = (unsigned)t * (unsigned)(TG * 1024 * 2); colt = (u.pn & 3) * 256; silu = (t == 0); }
#pragma unroll
        for (int ai = 0; ai < 2; ++ai)
#pragma unroll
            for (int m = 0; m < 4; ++m) { const int row = rowb + ai * 128 + m * 16; float rsq = 1.0f; if (ACT == 2) rsq = *at<const float>(rs2, 4u * (unsigned)row);
#pragma unroll
                for (int bj = 0; bj < 2; ++bj) { f32x4 v[2] = {acc[ai][bj][m][0], acc[ai][bj][m][1]};
#pragma unroll
                    for (int n = 0; n < 2; ++n)
#pragma unroll
                        for (int j = 0; j < 4; ++j) { const float x = v[n][j];
                            if (ACT == 1) { const float sg = sigmoidf_(x); v[n][j] = silu ? x * sg : sg; }
                            else { const float r = fmaxf(x, 0.f); v[n][j] = r * r * rsq; } }
                    *at<u32x4>(O, boff + 2u * (unsigned)(row * ldc + colt + bj * 128 + wc * 32 + 8 * fq)) = pack8(v[0], v[1]); } }
    }
};

struct Epi4 {
    static constexpr bool PERM = true;
    const bf16_t* SGA; bf16_t* MA;
    __device__ __forceinline__ void operator()(const AccT& acc, const pg8::Unit& u, int wr, int wc, int fr, int fq) const {
        asm volatile("" : "+v"(fr), "+v"(fq), "+s"(wr), "+s"(wc));
        const int rowb = u.pm * 256 + wr * 64 + fr;
#pragma unroll
        for (int ai = 0; ai < 2; ++ai)
#pragma unroll
            for (int m = 0; m < 4; ++m) { const int row = rowb + ai * 128 + m * 16;
#pragma unroll
                for (int bj = 0; bj < 2; ++bj) { const unsigned off = (unsigned)(row * 1024 + u.pn * 256 + bj * 128 + wc * 32 + 8 * fq);
                    const u32x4 gq = *at<const u32x4>(SGA, 2u * off); const f32x4 a0 = acc[ai][bj][m][0], a1 = acc[ai][bj][m][1];
                    f32x4 o0, o1; o0[0] = a0[0] * bf_lo(gq.x); o0[1] = a0[1] * bf_hi(gq.x); o0[2] = a0[2] * bf_lo(gq.y); o0[3] = a0[3] * bf_hi(gq.y);
                    o1[0] = a1[0] * bf_lo(gq.z); o1[1] = a1[1] * bf_hi(gq.z); o1[2] = a1[2] * bf_lo(gq.w); o1[3] = a1[3] * bf_hi(gq.w);
                    *at<u32x4>(MA, 2u * off) = pack8(o0, o1); } }
    }
};
struct Epi5 {
    static constexpr bool PERM = true;
    const bf16_t* SGB; const bf16_t* MA; bf16_t* MG;
    __device__ __forceinline__ void operator()(const AccT& acc, const pg8::Unit& u, int wr, int wc, int fr, int fq) const {
        asm volatile("" : "+v"(fr), "+v"(fq), "+s"(wr), "+s"(wc));
        const int rowb = u.pm * 256 + wr * 64 + fr;
#pragma unroll
        for (int ai = 0; ai < 2; ++ai)
#pragma unroll
            for (int m = 0; m < 4; ++m) { const int row = rowb + ai * 128 + m * 16;
#pragma unroll
                for (int bj = 0; bj < 2; ++bj) { const unsigned off = (unsigned)(row * 1024 + u.pn * 256 + bj * 128 + wc * 32 + 8 * fq);
                    const u32x4 gq = *at<const u32x4>(SGB, 2u * off); const f32x4 a0 = acc[ai][bj][m][0], a1 = acc[ai][bj][m][1];
                    const u32x4 mq = *at<const u32x4>(MA, 2u * off); f32x4 o0 = (f32x4){bf_lo(mq.x), bf_hi(mq.x), bf_lo(mq.y), bf_hi(mq.y)}, o1 = (f32x4){bf_lo(mq.z), bf_hi(mq.z), bf_lo(mq.w), bf_hi(mq.w)};
                    o0[0] += a0[0] * bf_lo(gq.x); o0[1] += a0[1] * bf_hi(gq.x); o0[2] += a0[2] * bf_lo(gq.y); o0[3] += a0[3] * bf_hi(gq.y);
                    o1[0] += a1[0] * bf_lo(gq.z); o1[1] += a1[1] * bf_hi(gq.z); o1[2] += a1[2] * bf_lo(gq.w); o1[3] += a1[3] * bf_hi(gq.w);
                    *at<u32x4>(MG, 2u * off) = pack8(o0, o1); } }
    }
};
struct EpiF32Ssq {
    static constexpr bool PERM = true;
    bf16_t* O; float* ssq;
    __device__ __forceinline__ void operator()(const AccT& acc, const pg8::Unit& u, int wr, int wc, int fr, int fq) const {
        asm volatile("" : "+v"(fr), "+v"(fq), "+s"(wr), "+s"(wc));
        const int rowb = u.pm * 256 + wr * 64 + fr;
#pragma unroll
        for (int ai = 0; ai < 2; ++ai)
#pragma unroll
            for (int m = 0; m < 4; ++m) { const int row = rowb + ai * 128 + m * 16; float s = 0.f;
#pragma unroll
                for (int bj = 0; bj < 2; ++bj) { const unsigned off = (unsigned)(row * 1024 + u.pn * 256 + bj * 128 + wc * 32 + 8 * fq); const f32x4 v0 = acc[ai][bj][m][0], v1 = acc[ai][bj][m][1];
                    s += (v0[0] * v0[0] + v0[1] * v0[1]) + (v0[2] * v0[2] + v0[3] * v0[3]) + (v1[0] * v1[0] + v1[1] * v1[1]) + (v1[2] * v1[2] + v1[3] * v1[3]);
                    *at<u32x4>(O, 2u * off) = pack8(v0, v1); }
                s += __shfl_xor(s, 16); s += __shfl_xor(s, 32);
                if (fq == 0) atomic_addf(at<float>(ssq, 4u * (unsigned)row), s); }
    }
};

struct Args {
    const float* x_prompt; const float* x_sample; const float* g_pre_mix; const float* w_in; const float* g_q_norm; const float* w_q_up;
    const float* g_kv_norm; const float* w_kv_up; const float* w_branch_a; const float* ldf; const float* ldb; const float* w_branch_b;
    const float* w_out; const float* g_post_mix; const float* g_pre_mlp; const float* w_up; const float* w_down; const float* g_post_mlp;
    float* out; unsigned char* ws;
};

__device__ __forceinline__ int src_col(int mode, int n, int coff) {
    if (mode == 0) return coff + n;
    if (mode == 1) {
        if (n < 256) return n;
        if (n < 384) return n;
        if (n < 416) { const int c = n - 384; return 384 + 16 * ((c >> 2) & 1) + 4 * (c >> 3) + (c & 3); }
        if (n < 512) return -1;
        if (n < 1536) { const int c = (n - 512) & 511, base = (n < 1024) ? 416 : 928; const int head = c >> 6, w = c & 63; return base + 64 * head + 32 * ((w >> 2) & 1) + 4 * (w >> 3) + (w & 3); }
        return 1440 + (n - 1536);
    }
    if (mode == 2) {
        if (n < 512) return 96 * (n >> 6) + (n & 63);
        const int c = n - 512, head = c >> 5, w = c & 31; return 96 * head + 64 + 16 * ((w >> 2) & 1) + 4 * (w >> 3) + (w & 3);
    }
    if (n < 512) return 128 * (n >> 6) + (n & 63);
    { const int c = n - 512; return 128 * (c >> 6) + 64 + (c & 63); }
}
struct CW { const float* W; int ldw, K, Nout, mode, coff; const float* gk; bf16_t* out; };
__device__ __forceinline__ void convert_item(const CW& c, int it) {
    const int n = it % c.Nout, kb = (it / c.Nout) * 64; const int sc = src_col(c.mode, n, c.coff);
#pragma unroll 2
    for (int sub = 0; sub < 8; ++sub) { const int k0 = kb + 8 * sub;
        float v[8];
#pragma unroll
        for (int e = 0; e < 8; ++e) { float x = (sc >= 0) ? c.W[(size_t)(k0 + e) * c.ldw + sc] : 0.f; if (c.gk) x *= c.gk[k0 + e]; v[e] = x; }
        u32x4 w; w.x = pg8::cvt_pk_bf16(v[0], v[1]); w.y = pg8::cvt_pk_bf16(v[2], v[3]); w.z = pg8::cvt_pk_bf16(v[4], v[5]); w.w = pg8::cvt_pk_bf16(v[6], v[7]);
        *(u32x4*)(c.out + (size_t)n * c.K + k0) = w; }
}

__device__ __forceinline__ float ssq4(const f32x4& v) { return (v[0] * v[0] + v[1] * v[1]) + (v[2] * v[2] + v[3] * v[3]); }
__device__ __forceinline__ u32x2 pk4(const f32x4& y) { u32x2 w; w.x = pg8::cvt_pk_bf16(y[0], y[1]); w.y = pg8::cvt_pk_bf16(y[2], y[3]); return w; }
__device__ __forceinline__ f32x4 unpk4(const u32x2& w) { return (f32x4){bf_lo(w.x), bf_hi(w.x), bf_lo(w.y), bf_hi(w.y)}; }
constexpr int RP_NR = 2;
__device__ __forceinline__ void rowpass0(const float* x, const float* g, bf16_t* HBF, int gw, int ngw, int lane) {
    f32x4 gv[4];
#pragma unroll
    for (int j = 0; j < 4; ++j) gv[j] = ((const f32x4*)g)[64 * j + lane];
    for (int r = gw; r < TG; r += RP_NR * ngw) {
        f32x4 v[RP_NR][4]; int rr[RP_NR];
#pragma unroll
        for (int k = 0; k < RP_NR; ++k) { rr[k] = (r + k * ngw < TG) ? r + k * ngw : r; const f32x4* xr = (const f32x4*)(x + (size_t)rr[k] * DM) + lane;
#pragma unroll
            for (int j = 0; j < 4; ++j) v[k][j] = __builtin_nontemporal_load(xr + 64 * j); }
#pragma unroll
        for (int k = 0; k < RP_NR; ++k) { float s = 0.f;
#pragma unroll
            for (int j = 0; j < 4; ++j) s += ssq4(v[k][j]);
            const float rs = rsqrtf(wave_sum(s) * (1.0f / DM) + EPS); u32x2* o = (u32x2*)(HBF + (size_t)rr[k] * DM) + lane;
#pragma unroll
            for (int j = 0; j < 4; ++j) o[64 * j] = pk4(v[k][j] * rs * gv[j]); }
    }
}
__device__ __forceinline__ void rowpass1(const float* x, const bf16_t* MF, const float* ssq_m, const float* g1, bf16_t* X1, float* rs2, int gw, int ngw, int lane) {
    f32x4 g1v[4];
#pragma unroll
    for (int j = 0; j < 4; ++j) g1v[j] = ((const f32x4*)g1)[64 * j + lane];
    for (int r = gw; r < TG; r += RP_NR * ngw) {
        f32x4 v[RP_NR][4]; u32x2 wv[RP_NR][4]; int rr[RP_NR]; float rm[RP_NR];
#pragma unroll
        for (int k = 0; k < RP_NR; ++k) { rr[k] = (r + k * ngw < TG) ? r + k * ngw : r; const f32x4* xr = (const f32x4*)(x + (size_t)rr[k] * DM) + lane; const u32x2* mr = (const u32x2*)(MF + (size_t)rr[k] * DM) + lane;
            rm[k] = ssq_m[rr[k]];
#pragma unroll
            for (int j = 0; j < 4; ++j) { v[k][j] = __builtin_nontemporal_load(xr + 64 * j); wv[k][j] = __builtin_nontemporal_load(mr + 64 * j); } }
#pragma unroll
        for (int k = 0; k < RP_NR; ++k) { const float rmk = rsqrtf(rm[k] * (1.0f / DM) + EPS); float s = 0.f;
#pragma unroll
            for (int j = 0; j < 4; ++j) { v[k][j] = v[k][j] + unpk4(wv[k][j]) * rmk * g1v[j]; s += ssq4(v[k][j]); }
            const float rs = rsqrtf(wave_sum(s) * (1.0f / DM) + EPS);
            u32x2* orow = (u32x2*)(X1 + (size_t)rr[k] * DM) + lane; if (lane == 0) rs2[rr[k]] = rs * rs;
#pragma unroll
            for (int j = 0; j < 4; ++j) orow[64 * j] = pk4(v[k][j]); }
    }
}
__device__ __forceinline__ void rowpass2(const bf16_t* X1, const bf16_t* DF, const float* ssq_d, const float* g3, float* out, int gw, int ngw, int lane) {
    f32x4 g3v[4];
#pragma unroll
    for (int j = 0; j < 4; ++j) g3v[j] = ((const f32x4*)g3)[64 * j + lane];
    for (int r = gw; r < TG; r += RP_NR * ngw) {
        u32x2 xv[RP_NR][4]; u32x2 wv[RP_NR][4]; int rr[RP_NR]; float rd[RP_NR];
#pragma unroll
        for (int k = 0; k < RP_NR; ++k) { rr[k] = (r + k * ngw < TG) ? r + k * ngw : r; const u32x2* xr = (const u32x2*)(X1 + (size_t)rr[k] * DM) + lane; const u32x2* dr = (const u32x2*)(DF + (size_t)rr[k] * DM) + lane;
            rd[k] = ssq_d[rr[k]];
#pragma unroll
            for (int j = 0; j < 4; ++j) { xv[k][j] = __builtin_nontemporal_load(xr + 64 * j); wv[k][j] = __builtin_nontemporal_load(dr + 64 * j); } }
        asm volatile("" ::: "memory");
#pragma unroll
        for (int k = 0; k < RP_NR; ++k) { const float rdk = rsqrtf(rd[k] * (1.0f / DM) + EPS); f32x4* orow = (f32x4*)(out + (size_t)rr[k] * DM) + lane;
#pragma unroll
            for (int j = 0; j < 4; ++j) __builtin_nontemporal_store(unpk4(xv[k][j]) + unpk4(wv[k][j]) * rdk * g3v[j], orow + 64 * j); }
    }
}

#define LDS_BARRIER() asm volatile("s_waitcnt lgkmcnt(0)\n\ts_barrier" ::: "memory")
__device__ __forceinline__ void gload16_async(u32x4& r, const void* base, unsigned off) { r = *at<const u32x4>(base, off); }
#define VM_WAIT_N(n) asm volatile("s_waitcnt vmcnt(" #n ")" ::: "memory")
constexpr int AT_KP = 208, AT_VP = 144, AT_KB = 64 * AT_KP, AT_VB = 64 * AT_VP, AT_STAGE = AT_KB + AT_VB;
__device__ __forceinline__ void attn_phase(LAS unsigned char* lds, bf16_t* QN, bf16_t* OUT, const bf16_t* QR, const bf16_t* KN, const bf16_t* KR, const bf16_t* VT, int slog, int nseq, int vcu, int G) {
    int tid_ = threadIdx.x; asm volatile("" : "+v"(tid_));
    const int tid = tid_, w = __builtin_amdgcn_readfirstlane(tid >> 6), grp = w >> 2, lane = tid & 63, qi = lane & 31, hi = lane >> 5;
    const int S = 1 << slog, nqb = S >> 8, nunits = nseq * 8 * nqb, ntile = S >> 6;
    const int lk_row = tid >> 3, lk_c = tid & 7;
    const int lr_row = (tid & 255) >> 2, lr_c = tid & 3;
    const int lv_row = tid >> 3, lv_c = tid & 7;
    if (grp == 1) __builtin_amdgcn_s_setprio(1);
    for (int un = vcu; un < nunits; un += G) {
        const int qb = un % nqb, sh = un / nqb, h = sh & 7, seq = sh >> 3;
        const unsigned tokq = (unsigned)(seq * S + qb * 256 + w * 32 + qi);
        bf16x8 Qf[6];
#pragma unroll
        for (int s = 0; s < 4; ++s) Qf[s] = *at<const bf16x8>(QN, 2u * (tokq * 512u + (unsigned)(64 * h + 16 * s + 8 * hi)));
#pragma unroll
        for (int s = 0; s < 2; ++s) Qf[4 + s] = *at<const bf16x8>(QR, 2u * (tokq * 256u + (unsigned)(32 * h + 16 * s + 8 * hi)));
        f32x16 o0, o1, negm, p0, p1;
#pragma unroll
        for (int i = 0; i < 16; ++i) { o0[i] = 0.f; o1[i] = 0.f; negm[i] = 0.f; p0[i] = 0.f; p1[i] = 0.f; }
        float lsum = 0.f;
        const unsigned kn_off = 2u * (unsigned)((seq * S + lk_row) * 512 + 64 * h + 8 * lk_c);
        const unsigned kr_off = 2u * (unsigned)((seq * S + lr_row) * 32 + 8 * lr_c);
        const unsigned vt_off = 2u * (unsigned)(((seq * 8 + h) * 64 + lv_row) * S + 8 * lv_c);
        u32x4 rk = (u32x4){0u, 0u, 0u, 0u}, rr = rk, rv = rk, rk2 = rk, rr2 = rk, rv2 = rk;
        gload16_async(rk, KN, kn_off); gload16_async(rr, KR, kr_off); gload16_async(rv, VT, vt_off);
        VM_WAIT_N(0);
        LDS_BARRIER();
        *(LAS u32x4*)(lds + lk_row * AT_KP + 16 * lk_c) = rk;
        *(LAS u32x4*)(lds + AT_KB + lv_row * AT_VP + 16 * lv_c) = rv;
        if (tid < 256) *(LAS u32x4*)(lds + lr_row * AT_KP + 128 + 16 * lr_c) = rr;
        gload16_async(rk, KN, kn_off + 65536u); gload16_async(rr, KR, kr_off + 4096u); gload16_async(rv, VT, vt_off + 128u);
        gload16_async(rk2, KN, kn_off + 2u * 65536u); gload16_async(rr2, KR, kr_off + 2u * 4096u); gload16_async(rv2, VT, vt_off + 2u * 128u);
        LDS_BARRIER();
#define AT_H1(T) do { LAS unsigned char* Ks = lds + ((T) & 1) * AT_STAGE; \
            bf16x8 kf[6], kg[6]; \
            _Pragma("unroll") for (int s = 0; s < 3; ++s) { kf[2 * s] = *(const LAS bf16x8*)(Ks + qi * AT_KP + 32 * s + 16 * hi); kf[2 * s + 1] = *(const LAS bf16x8*)(Ks + (32 + qi) * AT_KP + 32 * s + 16 * hi); } \
            __builtin_amdgcn_sched_barrier(0); \
            _Pragma("unroll") for (int s = 3; s < 6; ++s) { kg[2 * (s - 3)] = *(const LAS bf16x8*)(Ks + qi * AT_KP + 32 * s + 16 * hi); kg[2 * (s - 3) + 1] = *(const LAS bf16x8*)(Ks + (32 + qi) * AT_KP + 32 * s + 16 * hi); } \
            p0 = __builtin_amdgcn_mfma_f32_32x32x16_bf16(kf[0], Qf[0], negm, 0, 0, 0); p1 = __builtin_amdgcn_mfma_f32_32x32x16_bf16(kf[1], Qf[0], negm, 0, 0, 0); \
            _Pragma("unroll") for (int s = 1; s < 3; ++s) { p0 = __builtin_amdgcn_mfma_f32_32x32x16_bf16(kf[2 * s], Qf[s], p0, 0, 0, 0); p1 = __builtin_amdgcn_mfma_f32_32x32x16_bf16(kf[2 * s + 1], Qf[s], p1, 0, 0, 0); } \
            __builtin_amdgcn_sched_barrier(0); \
            _Pragma("unroll") for (int s = 3; s < 6; ++s) { p0 = __builtin_amdgcn_mfma_f32_32x32x16_bf16(kg[2 * (s - 3)], Qf[s], p0, 0, 0, 0); p1 = __builtin_amdgcn_mfma_f32_32x32x16_bf16(kg[2 * (s - 3) + 1], Qf[s], p1, 0, 0, 0); } \
        } while (0)
#define AT_H2(T) do { const int t_ = (T); LAS unsigned char* Vs = lds + (t_ & 1) * AT_STAGE + AT_KB; \
            bf16x8 vf[4], vg[4]; \
            _Pragma("unroll") for (int s2 = 0; s2 < 2; ++s2) { vf[2 * s2] = *(const LAS bf16x8*)(Vs + qi * AT_VP + 32 * s2 + 16 * hi); vf[2 * s2 + 1] = *(const LAS bf16x8*)(Vs + (32 + qi) * AT_VP + 32 * s2 + 16 * hi); } \
            __builtin_amdgcn_sched_barrier(0); \
            float mxa = fmaxf(p0[0], p1[0]), mxb = fmaxf(p0[1], p1[1]), mxc = fmaxf(p0[2], p1[2]), mxd = fmaxf(p0[3], p1[3]); \
            _Pragma("unroll") for (int i = 4; i < 16; i += 4) { mxa = fmaxf(mxa, fmaxf(p0[i], p1[i])); mxb = fmaxf(mxb, fmaxf(p0[i + 1], p1[i + 1])); mxc = fmaxf(mxc, fmaxf(p0[i + 2], p1[i + 2])); mxd = fmaxf(mxd, fmaxf(p0[i + 3], p1[i + 3])); } \
            float mx = fmaxf(fmaxf(mxa, mxb), fmaxf(mxc, mxd)); \
            const bool resc = (t_ == 0) || (mx > 8.0f); \
            if (__builtin_amdgcn_ballot_w64(resc) != 0ull) { \
                mx = fmaxf(mx, __shfl_xor(mx, 32)); \
                const float d = (t_ == 0) ? mx : fmaxf(mx, 0.f); const float alpha = (t_ == 0) ? 1.0f : fast_exp2(-d); \
                lsum *= alpha; \
                _Pragma("unroll") for (int i = 0; i < 16; ++i) { o0[i] *= alpha; o1[i] *= alpha; p0[i] -= d; p1[i] -= d; negm[i] -= d; } \
            } \
            float rsa = 0.f, rsb = 0.f, rsc = 0.f, rsd = 0.f; \
            _Pragma("unroll") for (int i = 0; i < 16; i += 4) { \
                p0[i] = fast_exp2(p0[i]); p1[i] = fast_exp2(p1[i]); p0[i + 1] = fast_exp2(p0[i + 1]); p1[i + 1] = fast_exp2(p1[i + 1]); \
                p0[i + 2] = fast_exp2(p0[i + 2]); p1[i + 2] = fast_exp2(p1[i + 2]); p0[i + 3] = fast_exp2(p0[i + 3]); p1[i + 3] = fast_exp2(p1[i + 3]); \
                rsa += p0[i] + p1[i]; rsb += p0[i + 1] + p1[i + 1]; rsc += p0[i + 2] + p1[i + 2]; rsd += p0[i + 3] + p1[i + 3]; } \
            lsum += (rsa + rsb) + (rsc + rsd); \
            bf16x8 pf[2][2]; \
            _Pragma("unroll") for (int s2 = 0; s2 < 2; ++s2) { u32x4 a, b; \
                a.x = pg8::cvt_pk_bf16(p0[8 * s2 + 0], p0[8 * s2 + 1]); a.y = pg8::cvt_pk_bf16(p0[8 * s2 + 2], p0[8 * s2 + 3]); a.z = pg8::cvt_pk_bf16(p0[8 * s2 + 4], p0[8 * s2 + 5]); a.w = pg8::cvt_pk_bf16(p0[8 * s2 + 6], p0[8 * s2 + 7]); \
                b.x = pg8::cvt_pk_bf16(p1[8 * s2 + 0], p1[8 * s2 + 1]); b.y = pg8::cvt_pk_bf16(p1[8 * s2 + 2], p1[8 * s2 + 3]); b.z = pg8::cvt_pk_bf16(p1[8 * s2 + 4], p1[8 * s2 + 5]); b.w = pg8::cvt_pk_bf16(p1[8 * s2 + 6], p1[8 * s2 + 7]); \
                pf[0][s2] = __builtin_bit_cast(bf16x8, a); pf[1][s2] = __builtin_bit_cast(bf16x8, b); } \
            _Pragma("unroll") for (int s2 = 0; s2 < 2; ++s2) { vg[2 * s2] = *(const LAS bf16x8*)(Vs + qi * AT_VP + 64 + 32 * s2 + 16 * hi); vg[2 * s2 + 1] = *(const LAS bf16x8*)(Vs + (32 + qi) * AT_VP + 64 + 32 * s2 + 16 * hi); } \
            _Pragma("unroll") for (int s2 = 0; s2 < 2; ++s2) { o0 = __builtin_amdgcn_mfma_f32_32x32x16_bf16(vf[2 * s2], pf[0][s2], o0, 0, 0, 0); o1 = __builtin_amdgcn_mfma_f32_32x32x16_bf16(vf[2 * s2 + 1], pf[0][s2], o1, 0, 0, 0); } \
            __builtin_amdgcn_sched_barrier(0); \
            _Pragma("unroll") for (int s2 = 0; s2 < 2; ++s2) { o0 = __builtin_amdgcn_mfma_f32_32x32x16_bf16(vg[2 * s2], pf[1][s2], o0, 0, 0, 0); o1 = __builtin_amdgcn_mfma_f32_32x32x16_bf16(vg[2 * s2 + 1], pf[1][s2], o1, 0, 0, 0); } \
        } while (0)
#define AT_FEEDK(TN, RK, RR) do { const int tn_ = (TN); const unsigned tl_ = (unsigned)((tn_ + 2 < ntile) ? tn_ + 2 : ntile - 1); LAS unsigned char* Kn_ = lds + (tn_ & 1) * AT_STAGE; \
            *(LAS u32x4*)(Kn_ + lk_row * AT_KP + 16 * lk_c) = RK; \
            if (tid < 256) *(LAS u32x4*)(Kn_ + lr_row * AT_KP + 128 + 16 * lr_c) = RR; \
            gload16_async(RK, KN, kn_off + tl_ * 65536u); gload16_async(RR, KR, kr_off + tl_ * 4096u); \
            LDS_BARRIER(); } while (0)
#define AT_FEEDV(TN, RV) do { const int tn_ = (TN); const unsigned tl_ = (unsigned)((tn_ + 2 < ntile) ? tn_ + 2 : ntile - 1); LAS unsigned char* Kn_ = lds + (tn_ & 1) * AT_STAGE; \
            *(LAS u32x4*)(Kn_ + AT_KB + lv_row * AT_VP + 16 * lv_c) = RV; \
            gload16_async(RV, VT, vt_off + tl_ * 128u); \
            LDS_BARRIER(); } while (0)
        if (grp == 0) {
            for (int t = 0; t < ntile; t += 2) {
                AT_H1(t); AT_FEEDK(t + 1, rk, rr); AT_H2(t); AT_FEEDV(t + 1, rv);
                AT_H1(t + 1); AT_FEEDK(t + 2, rk2, rr2); AT_H2(t + 1); AT_FEEDV(t + 2, rv2);
            }
            AT_FEEDK(ntile + 1, rk, rr);
        } else {
            AT_FEEDK(1, rk, rr);
            for (int t = 0; t < ntile; t += 2) {
                AT_H1(t); AT_FEEDV(t + 1, rv); AT_H2(t); AT_FEEDK(t + 2, rk2, rr2);
                AT_H1(t + 1); AT_FEEDV(t + 2, rv2); AT_H2(t + 1); AT_FEEDK(t + 3, rk, rr);
            }
        }
#undef AT_FEEDK
#undef AT_FEEDV
#undef AT_H1
#undef AT_H2
        VM_WAIT_N(0);
        lsum += __shfl_xor(lsum, 32);
        const float inv = 1.0f / lsum;
        const unsigned op = 2u * (tokq * 512u + (unsigned)(64 * h + 4 * hi));
#pragma unroll
        for (int g4 = 0; g4 < 4; ++g4) {
            u32x2 a, b;
            a.x = pg8::cvt_pk_bf16(o0[4 * g4 + 0] * inv, o0[4 * g4 + 1] * inv); a.y = pg8::cvt_pk_bf16(o0[4 * g4 + 2] * inv, o0[4 * g4 + 3] * inv);
            b.x = pg8::cvt_pk_bf16(o1[4 * g4 + 0] * inv, o1[4 * g4 + 1] * inv); b.y = pg8::cvt_pk_bf16(o1[4 * g4 + 2] * inv, o1[4 * g4 + 3] * inv);
            *at<u32x2>(OUT, op + 16u * g4) = a; *at<u32x2>(OUT, op + 64u + 16u * g4) = b;
        }
    }
    __builtin_amdgcn_s_setprio(0);
    __syncthreads();
}

constexpr int RA_P = 288;
__device__ __forceinline__ void retA_phase(LAS unsigned char* lds, const bf16_t* RK, const bf16_t* RVT, bf16_t* ST, const float* ldf, const float* ldb, int slog, int nseq, int vcu, int G) {
    int tid_ = threadIdx.x; asm volatile("" : "+v"(tid_));
    const int tid = tid_, w = tid >> 6, lane = tid & 63, r16 = lane & 15, q = lane >> 4;
    const int S = 1 << slog, nch = S >> 7, nunits = nseq * 8 * nch;
    const int var = w >> 2, dvb = (w & 3) * 32;
    const int key = tid >> 2, d0 = (tid & 3) * 16;
#define RA_LOAD(UN) do { const int un_ = (UN); const int ch_ = un_ % nch, sh_ = un_ / nch, h_ = sh_ & 7, seq_ = sh_ >> 3; const size_t tokc_ = (size_t)seq_ * S + ch_ * 128; \
        pa = *(const u32x4*)(RK + (tokc_ + key) * 512 + 64 * h_ + d0); pb = *(const u32x4*)(RK + (tokc_ + key) * 512 + 64 * h_ + d0 + 8); \
        _Pragma("unroll") for (int b2 = 0; b2 < 2; ++b2) _Pragma("unroll") for (int ks = 0; ks < 4; ++ks) \
            pvf[b2][ks] = *(const bf16x8*)(RVT + ((size_t)(seq_ * 8 + h_) * 128 + dvb + 16 * b2 + r16) * S + ch_ * 128 + 32 * ks + 8 * q); } while (0)
    u32x4 pa, pb; bf16x8 pvf[2][4];
    if (vcu < nunits) RA_LOAD(vcu);
    for (int un = vcu; un < nunits; un += G) {
        const int ch = un % nch, sh = un / nch, h = sh & 7, seq = sh >> 3;
        const size_t tokc = (size_t)seq * S + ch * 128;
        const float lgf = ldf[h] * LOG2E, lgb = ldb[h] * LOG2E;
        bf16x8 vf[2][4];
        {
            const u32x4 a = pa, b = pb;
#pragma unroll
            for (int b2 = 0; b2 < 2; ++b2)
#pragma unroll
                for (int ks = 0; ks < 4; ++ks) vf[b2][ks] = pvf[b2][ks];
            const float sf = fast_exp2(lgf * (float)(127 - key)), sb = fast_exp2(lgb * (float)key);
            const int kp = (key & ~31) | (8 * ((key >> 2) & 3) + 4 * ((key >> 4) & 1) + (key & 3));
            const unsigned wv[8] = {a.x, a.y, a.z, a.w, b.x, b.y, b.z, b.w};
#pragma unroll
            for (int e = 0; e < 8; ++e) { const float x0 = bf_lo(wv[e]), x1 = bf_hi(wv[e]);
                *(LAS bf16_t*)(lds + (d0 + 2 * e) * RA_P + 2 * kp) = f2bf(x0 * sf); *(LAS bf16_t*)(lds + (d0 + 2 * e + 1) * RA_P + 2 * kp) = f2bf(x1 * sf);
                *(LAS bf16_t*)(lds + 64 * RA_P + (d0 + 2 * e) * RA_P + 2 * kp) = f2bf(x0 * sb); *(LAS bf16_t*)(lds + 64 * RA_P + (d0 + 2 * e + 1) * RA_P + 2 * kp) = f2bf(x1 * sb); }
        }
        __syncthreads();
        if (un + G < nunits) RA_LOAD(un + G);
        f32x4 acc[4][2];
#pragma unroll
        for (int db = 0; db < 4; ++db)
#pragma unroll
            for (int b2 = 0; b2 < 2; ++b2) acc[db][b2] = (f32x4){0.f, 0.f, 0.f, 0.f};
        const LAS unsigned char* Kx = lds + var * 64 * RA_P;
#pragma unroll
        for (int db = 0; db < 4; ++db)
#pragma unroll
            for (int ks = 0; ks < 4; ++ks) { const bf16x8 kf = *(const LAS bf16x8*)(Kx + (16 * db + r16) * RA_P + 64 * ks + 16 * q);
#pragma unroll
                for (int b2 = 0; b2 < 2; ++b2) acc[db][b2] = __builtin_amdgcn_mfma_f32_16x16x32_bf16(kf, vf[b2][ks], acc[db][b2], 0, 0, 0); }
        bf16_t* stp = ST + ((size_t)((tokc >> 7) * 8 + h) * 2 + var) * 8192;
#pragma unroll
        for (int db = 0; db < 4; ++db)
#pragma unroll
            for (int b2 = 0; b2 < 2; ++b2) { u32x2 wv2; wv2.x = pg8::cvt_pk_bf16(acc[db][b2][0], acc[db][b2][1]); wv2.y = pg8::cvt_pk_bf16(acc[db][b2][2], acc[db][b2][3]);
                *(u32x2*)(stp + (dvb + 16 * b2 + r16) * 64 + 16 * db + 4 * q) = wv2; }
        __syncthreads();
    }
#undef RA_LOAD
}
__device__ __forceinline__ void retB_phase(bf16_t* ST, const float* ldf, const float* ldb, int slog, int nseq, long gtid, long gthreads) {
    const int S = 1 << slog, nch = S >> 7; const long items = (long)nseq * 8 * 2 * 1024;
    for (long it = gtid; it < items; it += gthreads) {
        const int vec = (int)(it & 1023), var = (int)((it >> 10) & 1), h = (int)((it >> 11) & 7), seq = (int)(it >> 14);
        const float gam = fast_exp2((var ? ldb[h] : ldf[h]) * LOG2E * 128.0f);
        float run[8];
#pragma unroll
        for (int e = 0; e < 8; ++e) run[e] = 0.f;
        for (int n0 = 0; n0 < nch; n0 += 16) {
            u32x4 v[16]; bf16_t* p[16];
#pragma unroll
            for (int j = 0; j < 16; ++j) { const int n = var ? (nch - 1 - (n0 + j)) : (n0 + j); p[j] = ST + ((size_t)((seq * nch + n) * 8 + h) * 2 + var) * 8192 + vec * 8; v[j] = *(const u32x4*)p[j]; }
#pragma unroll
            for (int j = 0; j < 16; ++j) {
                u32x4 o; o.x = pg8::cvt_pk_bf16(run[0], run[1]); o.y = pg8::cvt_pk_bf16(run[2], run[3]); o.z = pg8::cvt_pk_bf16(run[4], run[5]); o.w = pg8::cvt_pk_bf16(run[6], run[7]);
                *(u32x4*)p[j] = o;
                run[0] = run[0] * gam + bf_lo(v[j].x); run[1] = run[1] * gam + bf_hi(v[j].x); run[2] = run[2] * gam + bf_lo(v[j].y); run[3] = run[3] * gam + bf_hi(v[j].y);
                run[4] = run[4] * gam + bf_lo(v[j].z); run[5] = run[5] * gam + bf_hi(v[j].z); run[6] = run[6] * gam + bf_lo(v[j].w); run[7] = run[7] * gam + bf_hi(v[j].w);
            }
        }
    }
}
constexpr int RC_KP = 160, RC_VP = 288, RC_SP = 160;
constexpr int RC_K = 0, RC_V = 128 * RC_KP, RC_SF = RC_V + 128 * RC_VP, RC_SB = RC_SF + 128 * RC_SP;
__device__ __forceinline__ void retC_phase(LAS unsigned char* lds, const bf16_t* RQ, const bf16_t* RK, const bf16_t* RVT, const bf16_t* ST, const bf16_t* SRG, bf16_t* OB,
                                           const float* ldf, const float* ldb, int slog, int nseq, int vcu, int G) {
    int tid_ = threadIdx.x; asm volatile("" : "+v"(tid_));
    const int tid = tid_, w = tid >> 6, lane = tid & 63, r16 = lane & 15, q = lane >> 4;
    const int S = 1 << slog, nch = S >> 7, nunits = nseq * 8 * nch;
#define RC_LOAD(UN) do { const int un_ = (UN); const int ch_ = un_ % nch, sh_ = un_ / nch, h_ = sh_ & 7, seq_ = sh_ >> 3; const size_t tokc_ = (size_t)seq_ * S + ch_ * 128; \
        _Pragma("unroll") for (int i = 0; i < 2; ++i) { const int id = tid + 512 * i, row = id >> 3, c = id & 7; pk[i] = *(const u32x4*)(RK + (tokc_ + row) * 512 + 64 * h_ + 8 * c); } \
        _Pragma("unroll") for (int i = 0; i < 4; ++i) { const int id = tid + 512 * i, row = id >> 4, c = id & 15; pv[i] = *(const u32x4*)(RVT + ((size_t)(seq_ * 8 + h_) * 128 + row) * S + ch_ * 128 + 8 * c); } \
        const bf16_t* stf_ = ST + ((size_t)((tokc_ >> 7) * 8 + h_) * 2) * 8192; \
        _Pragma("unroll") for (int i = 0; i < 2; ++i) { const int id = tid + 512 * i, row = id >> 3, c = id & 7; psf[i] = *(const u32x4*)(stf_ + row * 64 + 8 * c); psb[i] = *(const u32x4*)(stf_ + 8192 + row * 64 + 8 * c); } \
        _Pragma("unroll") for (int s_ = 0; s_ < 2; ++s_) pq[s_] = *(const bf16x8*)(RQ + (tokc_ + 16 * w + r16) * 512 + 64 * h_ + 32 * s_ + 8 * q); } while (0)
    u32x4 pk[2], pv[4], psf[2], psb[2]; bf16x8 pq[2];
    if (vcu < nunits) RC_LOAD(vcu);
    for (int un = vcu; un < nunits; un += G) {
        const int ch = un % nch, sh = un / nch, h = sh & 7, seq = sh >> 3;
        const size_t tokc = (size_t)seq * S + ch * 128;
        const float lgf = ldf[h] * LOG2E, lgb = ldb[h] * LOG2E;
#pragma unroll
        for (int i = 0; i < 2; ++i) { const int id = tid + 512 * i, row = id >> 3, c = id & 7; *(LAS u32x4*)(lds + RC_K + row * RC_KP + 16 * c) = pk[i]; }
#pragma unroll
        for (int i = 0; i < 4; ++i) { const int id = tid + 512 * i, row = id >> 4, c = id & 15; *(LAS u32x4*)(lds + RC_V + row * RC_VP + 16 * c) = pv[i]; }
#pragma unroll
        for (int i = 0; i < 2; ++i) { const int id = tid + 512 * i, row = id >> 3, c = id & 7;
            *(LAS u32x4*)(lds + RC_SF + row * RC_SP + 16 * c) = psf[i]; *(LAS u32x4*)(lds + RC_SB + row * RC_SP + 16 * c) = psb[i]; }
        bf16x8 Qf[2];
#pragma unroll
        for (int s = 0; s < 2; ++s) Qf[s] = pq[s];
        __syncthreads();
        u32x2 gqv[8];
#pragma unroll
        for (int dvb = 0; dvb < 8; ++dvb) gqv[dvb] = *(const u32x2*)(SRG + (tokc + 16 * w + r16) * 1024 + 128 * h + 16 * dvb + 4 * q);
        if (un + G < nunits) RC_LOAD(un + G);
        const int iq = 16 * w + r16; const size_t tok = tokc + iq;
        bf16x8 pf[4];
#pragma unroll
        for (int ks = 0; ks < 4; ++ks) {
            f32x4 sa[2];
#pragma unroll
            for (int hb = 0; hb < 2; ++hb) { const int kb = 2 * ks + hb; sa[hb] = (f32x4){0.f, 0.f, 0.f, 0.f};
#pragma unroll
                for (int s = 0; s < 2; ++s) { const bf16x8 kf = *(const LAS bf16x8*)(lds + RC_K + (16 * kb + r16) * RC_KP + 64 * s + 16 * q);
                    sa[hb] = __builtin_amdgcn_mfma_f32_16x16x32_bf16(kf, Qf[s], sa[hb], 0, 0, 0); }
#pragma unroll
                for (int i = 0; i < 4; ++i) { const int j = 16 * kb + 4 * q + i; const int df = iq - j; const float arg = (df >= 0) ? lgf * (float)df : lgb * (float)(-df); sa[hb][i] *= fast_exp2(arg); } }
            u32x4 pk; pk.x = pg8::cvt_pk_bf16(sa[0][0], sa[0][1]); pk.y = pg8::cvt_pk_bf16(sa[0][2], sa[0][3]); pk.z = pg8::cvt_pk_bf16(sa[1][0], sa[1][1]); pk.w = pg8::cvt_pk_bf16(sa[1][2], sa[1][3]);
            pf[ks] = __builtin_bit_cast(bf16x8, pk);
        }
        bf16x8 Qff[2], Qfb[2];
        { const float cf = fast_exp2(lgf * (float)(iq + 1)), cb = fast_exp2(lgb * (float)(128 - iq));
#pragma unroll
          for (int s = 0; s < 2; ++s) { const u32x4 qv = __builtin_bit_cast(u32x4, Qf[s]); const unsigned wv[4] = {qv.x, qv.y, qv.z, qv.w}; u32x4 a, b; unsigned ra[4], rb[4];
#pragma unroll
              for (int e = 0; e < 4; ++e) { const float x0 = bf_lo(wv[e]), x1 = bf_hi(wv[e]); ra[e] = pg8::cvt_pk_bf16(x0 * cf, x1 * cf); rb[e] = pg8::cvt_pk_bf16(x0 * cb, x1 * cb); }
              a.x = ra[0]; a.y = ra[1]; a.z = ra[2]; a.w = ra[3]; b.x = rb[0]; b.y = rb[1]; b.z = rb[2]; b.w = rb[3];
              Qff[s] = __builtin_bit_cast(bf16x8, a); Qfb[s] = __builtin_bit_cast(bf16x8, b); } }
        f32x4 oacc[8]; float ss = 0.f;
#pragma unroll
        for (int dvb = 0; dvb < 8; ++dvb) { f32x4 o = (f32x4){0.f, 0.f, 0.f, 0.f};
#pragma unroll
            for (int ks = 0; ks < 4; ++ks) { const bf16x8 vfr = *(const LAS bf16x8*)(lds + RC_V + (16 * dvb + r16) * RC_VP + 64 * ks + 16 * q);
                o = __builtin_amdgcn_mfma_f32_16x16x32_bf16(vfr, pf[ks], o, 0, 0, 0); }
#pragma unroll
            for (int s = 0; s < 2; ++s) { const bf16x8 sf = *(const LAS bf16x8*)(lds + RC_SF + (16 * dvb + r16) * RC_SP + 64 * s + 16 * q);
                const bf16x8 sb = *(const LAS bf16x8*)(lds + RC_SB + (16 * dvb + r16) * RC_SP + 64 * s + 16 * q);
                o = __builtin_amdgcn_mfma_f32_16x16x32_bf16(sf, Qff[s], o, 0, 0, 0);
                o = __builtin_amdgcn_mfma_f32_16x16x32_bf16(sb, Qfb[s], o, 0, 0, 0); }
            oacc[dvb] = o; ss += (o[0] * o[0] + o[1] * o[1]) + (o[2] * o[2] + o[3] * o[3]); }
        ss += __shfl_xor(ss, 16); ss += __shfl_xor(ss, 32);
        const float rstd = rsqrtf(ss * (1.0f / 128.0f) + EPS);
#pragma unroll
        for (int dvb = 0; dvb < 8; ++dvb) { const size_t off = tok * 1024 + 128 * h + 16 * dvb + 4 * q; const u32x2 gq = gqv[dvb];
            const f32x4 o = oacc[dvb]; u32x2 wv2; wv2.x = pg8::cvt_pk_bf16(o[0] * rstd * bf_lo(gq.x), o[1] * rstd * bf_hi(gq.x)); wv2.y = pg8::cvt_pk_bf16(o[2] * rstd * bf_lo(gq.y), o[3] * rstd * bf_hi(gq.y));
            *(u32x2*)(OB + off) = wv2; }
        __syncthreads();
    }
#undef RC_LOAD
}

#define XB_TMO      128
#define XB_XCNT(j)  (256  + 64 * (j))
#define XB_XSUB(j)  (1280 + 64 * (j))
#define XB_XGEN(j)  (2304 + 64 * (j))
#define XB_TOP      3328
#define XB_TOPGEN   3392
#define XCD_BAR_WORDS 3456
#define XB_SPIN_CAP (1u << 18)
__device__ __forceinline__ unsigned xb_ld(unsigned* p)              { return __hip_atomic_load(p, __ATOMIC_RELAXED, __HIP_MEMORY_SCOPE_AGENT); }
__device__ __forceinline__ unsigned xb_add(unsigned* p, unsigned v) { return __hip_atomic_fetch_add(p, v, __ATOMIC_RELAXED, __HIP_MEMORY_SCOPE_AGENT); }
__device__ __forceinline__ unsigned xb_xcc_id() { return (unsigned)__builtin_amdgcn_s_getreg((3 << 11) | 20) & 0xFu; }
#define XB_SPIN(cond, bar) do { unsigned _sp = 0; while (cond) { __builtin_amdgcn_s_sleep(1); \
    if ((++_sp & 255u) == 0u) { if (xb_ld(&(bar)[XB_TMO])) break; if (_sp > XB_SPIN_CAP) { atomicAdd(&(bar)[XB_TMO], 1u); break; } } } } while (0)
struct XcdBarrier { unsigned* bar; unsigned x; volatile LAS unsigned* st; };
__device__ __forceinline__ XcdBarrier xcd_barrier_post(unsigned* bar, volatile LAS unsigned* st) {
    XcdBarrier b; b.bar = bar; b.x = xb_xcc_id(); b.st = st;
    if (threadIdx.x == 0) (void)xb_add(&bar[XB_XCNT(b.x)], 1u);
    return b;
}
__device__ __forceinline__ void xcd_barrier_complete(unsigned* bar, unsigned x, unsigned& nloc, unsigned& nx) {
    const unsigned G = gridDim.x * gridDim.y * gridDim.z;
    unsigned sum, cnt, mine, sp = 0u;
    for (;;) {
        sum = 0u; cnt = 0u; mine = 0u;
#pragma unroll
        for (unsigned j = 0; j < 16; ++j) { const unsigned c = xb_ld(&bar[XB_XCNT(j)]); sum += c; cnt += (c > 0u) ? 1u : 0u; mine = (j == x) ? c : mine; }
        if (sum == G) break;
        __builtin_amdgcn_s_sleep(1);
        if ((++sp & 255u) == 0u) { if (xb_ld(&bar[XB_TMO])) break; if (sp > XB_SPIN_CAP) { atomicAdd(&bar[XB_TMO], 1u); break; } }
    }
    nloc = mine > 0u ? mine : 1u; nx = cnt > 0u ? cnt : 1u;
}
__device__ __forceinline__ void xcd_barrier(const XcdBarrier& b) {
    asm volatile("s_waitcnt vmcnt(0)" ::: "memory");
    __syncthreads();
    if (threadIdx.x == 0) {
        unsigned* bar = b.bar; asm volatile("" : "+s"(bar));
        __builtin_amdgcn_s_waitcnt(0);
        unsigned nloc = b.st[0], nx = b.st[1];
        if (nloc == 0u) { xcd_barrier_complete(bar, b.x, nloc, nx); b.st[0] = nloc; b.st[1] = nx; }
        const unsigned old = xb_add(&bar[XB_XSUB(b.x)], 1u);
        const unsigned gen = old / nloc;
        if (old + 1u == (gen + 1u) * nloc) {
            __builtin_amdgcn_fence(__ATOMIC_RELEASE, "agent");
            asm volatile("s_waitcnt vmcnt(0)" ::: "memory");
            const unsigned og = xb_add(&bar[XB_TOP], 1u);
            const unsigned tg = og / nx;
            if (og + 1u == (tg + 1u) * nx) xb_add(&bar[XB_TOPGEN], 1u);
            else XB_SPIN(xb_ld(&bar[XB_TOPGEN]) == tg, bar);
            __builtin_amdgcn_fence(__ATOMIC_ACQUIRE, "agent");
            xb_add(&bar[XB_XGEN(b.x)], 1u);
            asm volatile("s_waitcnt vmcnt(0)" ::: "memory");
        } else {
            XB_SPIN(xb_ld(&bar[XB_XGEN(b.x)]) == gen, bar);
            __builtin_amdgcn_fence(__ATOMIC_ACQUIRE, "agent");
            asm volatile("s_waitcnt vmcnt(0)" ::: "memory");
        }
    }
    __syncthreads();
}

#define WSP(off) (ws + (off))
#define SSQ ((float*)WSP(WS_SSQ))
#define W1A ((bf16_t*)WSP(WS_W1A))
#define W1B ((bf16_t*)WSP(WS_W1B))
#define WQ ((bf16_t*)WSP(WS_WQ))
#define WKV ((bf16_t*)WSP(WS_WKV))
#define WA ((bf16_t*)WSP(WS_WA))
#define WB ((bf16_t*)WSP(WS_WB))
#define WO ((bf16_t*)WSP(WS_WO))
#define WU ((bf16_t*)WSP(WS_WU))
#define WD ((bf16_t*)WSP(WS_WD))
#define HBF ((bf16_t*)WSP(A_HBF))
#define CQ ((bf16_t*)WSP(A_CQ))
#define CKV ((bf16_t*)WSP(A_CKV))
#define KR ((bf16_t*)WSP(A_KR))
#define RQ ((bf16_t*)WSP(A_RQ))
#define RK ((bf16_t*)WSP(A_RK))
#define RVT ((bf16_t*)WSP(A_RVT))
#define QN ((bf16_t*)WSP(A_QN))
#define QR ((bf16_t*)WSP(A_QR))
#define KN ((bf16_t*)WSP(A_KN))
#define VT ((bf16_t*)WSP(A_VT))
#define ST ((bf16_t*)WSP(A_ST))
#define G3 ((bf16_t*)WSP(A_G3))
#define SRG G3
#define SGA (G3 + (size_t)TG * 1024)
#define SGB (G3 + (size_t)2 * TG * 1024)
#define OB ((bf16_t*)WSP(A_OB))
#define MA ((bf16_t*)WSP(A_MA))
#define MG ((bf16_t*)WSP(A_MG))
#define MF ((bf16_t*)WSP(A_MF))
#define H2 ((bf16_t*)WSP(A_H2))
#define U ((bf16_t*)WSP(A_U))
#define DF ((bf16_t*)WSP(A_DF))
#define X1 ((bf16_t*)WSP(A_X1))
#define SSQP(g, k) (SSQ + (size_t)((g) * 4 + (k)) * TG)
#ifndef PHSEL
#define PHSEL -1
#endif
#define SEL(n) if constexpr (PHSEL < 0 || PHSEL == (n))
#define PHASE_BEGIN ArgsP ap = ap0; asm volatile("" : "+s"(ap)); unsigned char* ws = ap->ws; int tidp = threadIdx.x; asm volatile("" : "+v"(tidp)); \
    const int lane = tidp & 63, wave = tidp >> 6; const int vcu = (G % 8 == 0) ? (bx % 8) * (G / 8) + bx / 8 : bx; const long gtid = (long)bx * 512 + tidp, gthreads = (long)G * 512; const int gw = bx * 8 + wave, ngw = G * 8; \
    const float* xg = (g < 2) ? ap->x_prompt + (size_t)g * TG * DM : ap->x_sample; float* outg = ap->out + (size_t)g * TG * DM; \
    (void)lane; (void)vcu; (void)gtid; (void)gthreads; (void)gw; (void)ngw; (void)xg; (void)outg; (void)ws;

__global__ void __launch_bounds__(512, 2) fwd_megakernel(Args a_unused) {
    extern __shared__ __attribute__((aligned(16))) unsigned char lds_raw[];
    LAS unsigned char* lds = (LAS unsigned char*)lds_raw;
    cg::grid_group grid = cg::this_grid();
    typedef const __attribute__((address_space(4))) Args* ArgsP;
    ArgsP ap0 = (ArgsP)__builtin_amdgcn_kernarg_segment_ptr();
    const int G = gridDim.x, bx = blockIdx.x;
    volatile LAS unsigned* bst = (volatile LAS unsigned*)(lds + 131072 + 64);
    if (threadIdx.x < 2) bst[threadIdx.x] = 0u;
    __syncthreads();
    XcdBarrier xbar = xcd_barrier_post((unsigned*)(ap0->ws + WS_BAR), bst);
#define GSYNC() xcd_barrier(xbar)
    for (int g = 0; g < NGROUPS; ++g) {
        const int slog = (g < 2) ? 11 : 13, nseq = (g < 2) ? 16 : 4;

        if (g == 0) {
        { PHASE_BEGIN
            for (long i = gtid; i < (long)NGROUPS * 4 * TG; i += gthreads) SSQ[i] = 0.f;
            {
                constexpr int I0 = N1A * 16, I1 = N1B * 16, I2 = NQ * 4, I3 = NKV * 2, I4 = 1024 * 8, I5 = 1024 * 16, I6 = 1024 * 16, I7 = 4096 * 16, I8 = 1024 * 64;
                constexpr int ITOT = I0 + I1 + I2 + I3 + I4 + I5 + I6 + I7 + I8;
                for (int it = (int)gtid; it < ITOT; it += (int)gthreads) {
                    int r = it; CW c;
                    if (r < I0) c = CW{ap->w_in, 5536, 1024, N1A, 1, 0, nullptr, W1A};
                    else if ((r -= I0) < I1) c = CW{ap->w_in, 5536, 1024, N1B, 0, 2464, nullptr, W1B};
                    else if ((r -= I1) < I2) c = CW{ap->w_q_up, 768, 256, NQ, 2, 0, ap->g_q_norm, WQ};
                    else if ((r -= I2) < I3) c = CW{ap->w_kv_up, 1024, 128, NKV, 3, 0, ap->g_kv_norm, WKV};
                    else if ((r -= I3) < I4) c = CW{ap->w_branch_a, 1024, 512, 1024, 0, 0, nullptr, WA};
                    else if ((r -= I4) < I5) c = CW{ap->w_branch_b, 1024, 1024, 1024, 0, 0, nullptr, WB};
                    else if ((r -= I5) < I6) c = CW{ap->w_out, 1024, 1024, 1024, 0, 0, nullptr, WO};
                    else if ((r -= I6) < I7) c = CW{ap->w_up, 4096, 1024, 4096, 0, 0, ap->g_pre_mlp, WU};
                    else { r -= I7; c = CW{ap->w_down, 1024, 4096, 1024, 0, 0, nullptr, WD}; }
                    convert_item(c, r);
                }
            }
            rowpass0(xg, ap->g_pre_mix, HBF, gw, ngw, lane);
        }
        if (G == 0x7fffffff) grid.sync(); else GSYNC();
        }
        { PHASE_BEGIN
        SEL(1) { pg8::Gemm gm{HBF, W1A, TG, N1A, 1024}; pg8::StaticOrder S; S.init(TG, N1A, G, bx);
          Epi1 E{CQ, CKV, KR, RQ, RK, RVT, SSQP(g, 0), SSQP(g, 1), slog, lds + LDS_TSCR};
          pg8::gemm_phase<Epi1, pg8::StaticOrder, true, true>(lds, gm, S, E); }
        }
        GSYNC();
        { PHASE_BEGIN
        SEL(20) { pg8::Gemm gm{CQ, WQ, TG, NQ, 256}; pg8::StaticOrder S; S.init(TG, NQ, G, bx);
          Epi2q E{QN, QR, SSQP(g, 0), slog};
          pg8::gemm_phase<Epi2q, pg8::StaticOrder, true, true>(lds, gm, S, E); }
        SEL(21) { pg8::Gemm gm{CKV, WKV, TG, NKV, 128}; pg8::StaticOrder S; S.init(TG, NKV, G, bx);
          Epi2kv E{KN, VT, SSQP(g, 1), slog, lds + LDS_TSCR};
          pg8::gemm_phase<Epi2kv, pg8::StaticOrder, true, true>(lds, gm, S, E); }
        SEL(22) retA_phase(lds, RK, RVT, ST, ap->ldf, ap->ldb, slog, nseq, vcu, G);
#ifdef PROBE_RET2
        retA_phase(lds, RK, RVT, ST, ap->ldf, ap->ldb, slog, nseq, vcu, G);
#endif
        }
        GSYNC();
        { PHASE_BEGIN
        SEL(30) retB_phase(ST, ap->ldf, ap->ldb, slog, nseq, gtid, gthreads);
#ifdef PROBE_ATTN2
        attn_phase(lds, QN, OB, QR, KN, KR, VT, slog, nseq, vcu, G);
#endif
        SEL(31) attn_phase(lds, QN, QN, QR, KN, KR, VT, slog, nseq, vcu, G);
        SEL(32) { pg8::Gemm gm{HBF, W1B, TG, N1B, 1024}; pg8::StaticOrder S; S.init(TG, N1B, G, bx);
          EpiAct<1> E{G3, 1024, nullptr};
          pg8::gemm_phase<EpiAct<1>, pg8::StaticOrder, true, true>(lds, gm, S, E); }
        }
        GSYNC();
        { PHASE_BEGIN
        SEL(40) retC_phase(lds, RQ, RK, RVT, ST, SRG, OB, ap->ldf, ap->ldb, slog, nseq, vcu, G);
#ifdef PROBE_RET2
        retC_phase(lds, RQ, RK, RVT, ST, SRG, OB, ap->ldf, ap->ldb, slog, nseq, vcu, G);
#endif
        SEL(41) { pg8::Gemm gm{QN, WA, TG, 1024, 512}; pg8::StaticOrder S; S.init(TG, 1024, G, bx);
          Epi4 E{SGA, MA};
          pg8::gemm_phase<Epi4, pg8::StaticOrder, true, true>(lds, gm, S, E); }
        }
        GSYNC();
        { PHASE_BEGIN
        SEL(5) { pg8::Gemm gm{OB, WB, TG, 1024, 1024}; pg8::StaticOrder S; S.init(TG, 1024, G, bx);
          Epi5 E{SGB, MA, MG};
          pg8::gemm_phase<Epi5, pg8::StaticOrder, true, true>(lds, gm, S, E); }
        }
        GSYNC();
        { PHASE_BEGIN
        SEL(6) { pg8::Gemm gm{MG, WO, TG, 1024, 1024}; pg8::StaticOrder S; S.init(TG, 1024, G, bx);
          EpiF32Ssq E{MF, SSQP(g, 2)};
          pg8::gemm_phase<EpiF32Ssq, pg8::StaticOrder, true, true>(lds, gm, S, E); }
        }
        GSYNC();
        { PHASE_BEGIN
        SEL(7) rowpass1(xg, MF, SSQP(g, 2), ap->g_post_mix, X1, SSQP(g, 0), gw, ngw, lane);
        }
        GSYNC();
        { PHASE_BEGIN
        SEL(8) { pg8::Gemm gm{X1, WU, TG, DFF, 1024}; pg8::StaticOrder S; S.init(TG, DFF, G, bx);
          EpiAct<2> E{U, DFF, SSQP(g, 0)};
          pg8::gemm_phase<EpiAct<2>, pg8::StaticOrder, true, true>(lds, gm, S, E);
#ifdef PROBE_UP2
          pg8::gemm_phase<EpiAct<2>, pg8::StaticOrder, true, true>(lds, gm, S, E);
#endif
        }
        }
        GSYNC();
        { PHASE_BEGIN
        SEL(9) { pg8::Gemm gm{U, WD, TG, 1024, DFF}; pg8::StaticOrder S; S.init(TG, 1024, G, bx, 1);
          EpiF32Ssq E{DF, SSQP(g, 3)};
          pg8::gemm_phase<EpiF32Ssq, pg8::StaticOrder, true, true>(lds, gm, S, E); }
        }
        GSYNC();
        { PHASE_BEGIN
        SEL(10) rowpass2(X1, DF, SSQP(g, 3), ap->g_post_mlp, outg, gw, ngw, lane);
        if (g + 1 < NGROUPS) { const float* xn = (g + 1 < 2) ? ap->x_prompt + (size_t)(g + 1) * TG * DM : ap->x_sample; rowpass0(xn, ap->g_pre_mix, HBF, gw, ngw, lane); }
        }
        if (g + 1 < NGROUPS) GSYNC();
#ifdef PROBE_SYNC
        for (int i_ = 0; i_ < 10; ++i_) GSYNC();
#endif
    }
}

extern "C" void kernel_launch(void* const* d_in, const int* in_sizes, int n_in, void* d_out, int out_size, void* d_ws, size_t ws_size, hipStream_t stream) {
    static int grid = 0;
    if (grid == 0) {
        if (n_in != 18 || ws_size < WS_NEED) { fprintf(stderr, "kernel_launch: unexpected n_in %d / ws %zu (need %zu)\n", n_in, ws_size, (size_t)WS_NEED); grid = -1; return; }
        int dev = 0, cus = 0, per_cu = 0;
        (void)hipGetDevice(&dev); (void)hipDeviceGetAttribute(&cus, hipDeviceAttributeMultiprocessorCount, dev);
        if (hipFuncSetAttribute((const void*)fwd_megakernel, hipFuncAttributeMaxDynamicSharedMemorySize, LDS_BYTES) != hipSuccess) { fprintf(stderr, "hipFuncSetAttribute failed\n"); grid = -1; return; }
        if (hipOccupancyMaxActiveBlocksPerMultiprocessor(&per_cu, (const void*)fwd_megakernel, 512, LDS_BYTES) != hipSuccess || per_cu < 1) { fprintf(stderr, "occupancy query: %d\n", per_cu); per_cu = 1; }
        (void)hipGetLastError();
        grid = cus;
    }
    if (grid < 0) return;
    Args a{};
    a.x_prompt = (const float*)d_in[0]; a.x_sample = (const float*)d_in[1]; a.g_pre_mix = (const float*)d_in[2]; a.w_in = (const float*)d_in[3];
    a.g_q_norm = (const float*)d_in[4]; a.w_q_up = (const float*)d_in[5]; a.g_kv_norm = (const float*)d_in[6]; a.w_kv_up = (const float*)d_in[7];
    a.w_branch_a = (const float*)d_in[8]; a.ldf = (const float*)d_in[9]; a.ldb = (const float*)d_in[10]; a.w_branch_b = (const float*)d_in[11];
    a.w_out = (const float*)d_in[12]; a.g_post_mix = (const float*)d_in[13]; a.g_pre_mlp = (const float*)d_in[14]; a.w_up = (const float*)d_in[15];
    a.w_down = (const float*)d_in[16]; a.g_post_mlp = (const float*)d_in[17];
    a.out = (float*)d_out; a.ws = (unsigned char*)d_ws;
    if (hipMemsetAsync((char*)d_ws + WS_BAR, 0, 16384, stream) != hipSuccess) { fprintf(stderr, "memset failed\n"); return; }
    void* args[] = {&a};
    hipError_t e = hipLaunchCooperativeKernel((const void*)fwd_megakernel, dim3(grid), dim3(512), args, LDS_BYTES, stream);
    if (e != hipSuccess) fprintf(stderr, "cooperative launch failed: %s (grid %d)\n", hipGetErrorString(e), grid);
}
```

```cpp
#include <hip/hip_runtime.h>
#include <hip/hip_cooperative_groups.h>
#include <cstdio>
#include <cstdint>
namespace cg = cooperative_groups;

#define LAS __attribute__((address_space(3)))
typedef unsigned short bf16_t;
typedef short bf16x8 __attribute__((ext_vector_type(8)));
typedef float f32x4 __attribute__((ext_vector_type(4)));
typedef float f32x16 __attribute__((ext_vector_type(16)));
typedef unsigned u32x4 __attribute__((ext_vector_type(4)));
typedef unsigned u32x2 __attribute__((ext_vector_type(2)));

namespace pg8 {
constexpr int BM = 256, BK = 64, HALF = 128, HTB = HALF * BK * 2, STAGE_BYTES = 8 * HTB, NXCD = 8, WGM = 8;
__host__ __device__ __forceinline__ int lds_byte(int r, int c) { const int st = (r >> 4) * 2 + (c >> 5), rr = r & 15, cc = c & 31, ob = rr * 64 + cc * 2; return st * 1024 + (ob ^ (((ob >> 9) & 1) << 5)); }
__host__ __device__ __forceinline__ void stage_rc(int b, int& R, int& C) { const int st = b / 1024, sb = b % 1024, swz = sb ^ (((sb >> 9) & 1) << 5); R = (st >> 1) * 16 + swz / 64; C = (st & 1) * 32 + (swz % 64) / 2; }
__host__ __device__ __forceinline__ int perm32(int rho) { const int n = rho >> 4, i = rho & 15; return 8 * (i >> 2) + 4 * n + (i & 3); }

struct Unit { int pm, pn; };
struct Gemm { const bf16_t* A; const bf16_t* Bt; int M, N, K; };

struct StaticOrder {
    int nM, nN, nwg, G, c, rev;
    __host__ __device__ void init(int M, int N, int G_, int c_, int rev_ = 0) { nM = M / BM; nN = N / BM; nwg = nM * nN; G = G_; c = c_; rev = rev_; }
    __host__ __device__ bool next(int i, Unit& u) const {
        const long L = (long)i * G + c; if (L >= nwg) return false;
        int wgid = (int)L; { const int q = nwg / NXCD, r = nwg % NXCD, xcd = wgid % NXCD, off = wgid / NXCD; wgid = (xcd < r ? xcd * (q + 1) : r * (q + 1) + (xcd - r) * q) + off; }
        const int nig = WGM * nN, gid = wgid / nig, fm = gid * WGM, gsz = (nM - fm) < WGM ? (nM - fm) : WGM;
        u.pm = fm + ((wgid % nig) % gsz); u.pn = (wgid % nig) / gsz; if (rev) u.pm = nM - 1 - u.pm; return true;
    }
    __device__ __forceinline__ void a_ready(const Unit&) const {}
    __device__ __forceinline__ void done(const Unit&) const {}
};

__device__ __forceinline__ unsigned cvt_pk_bf16(float lo, float hi) { unsigned r; asm volatile("v_cvt_pk_bf16_f32 %0, %1, %2" : "=v"(r) : "v"(lo), "v"(hi)); return r; }

template <class Epi, class Sched, bool ALIGN_EPI = false, bool SP2 = false>
__device__ __forceinline__ void gemm_phase(LAS unsigned char* lds, const Gemm g, const Sched& S, const Epi& E) {
    int tid_ = threadIdx.x; asm volatile("" : "+v"(tid_));
    const int tid = tid_, wid = __builtin_amdgcn_readfirstlane(tid >> 6), lane = tid & 63, wr = wid >> 2, wc = wid & 3, fr = lane & 15, fq = lane >> 4;
    int K_ = g.K; asm volatile("" : "+s"(K_));
    const int K = K_, nt = K / BK;
    unsigned voffA[2], voffB[2];
#pragma unroll
    for (int i = 0; i < 2; ++i) { int R, C; stage_rc(tid * 16 + i * 8192, R, C); const int Rb = Epi::PERM ? ((R & ~31) + perm32(R & 31)) : R;
        voffA[i] = (unsigned)(R * K + C) * 2u; voffB[i] = (unsigned)(Rb * K + C) * 2u; }
    const size_t kstep = (size_t)(BK * 2);
    const size_t hstep = (size_t)HALF * K * 2;
    const size_t tstep = 2 * hstep;
    const unsigned ldsw = (unsigned)wid * 1024u;
    const int aoff = lds_byte(wr * 64 + fr, fq * 8), boff = lds_byte(wc * 32 + fr, fq * 8);
#define PG8_SA(b, h) (((b) * 2 + (h)) * HTB)
#define PG8_SB(b, h) ((4 + (b) * 2 + (h)) * HTB)
#define PG8_STAGE(bufoff, gbase, voff) do { _Pragma("unroll") for (int _i = 0; _i < 2; ++_i) \
        __builtin_amdgcn_global_load_lds((const unsigned*)((const char*)(gbase) + (voff)[_i]), (LAS unsigned*)(lds + (bufoff) + ldsw + _i * 8192), 16, 0, 0); } while (0)
#define PG8_LDA(dst, b, h) do { _Pragma("unroll") for (int m = 0; m < 4; ++m) _Pragma("unroll") for (int k = 0; k < 2; ++k) dst[m][k] = *(const LAS bf16x8*)(lds + PG8_SA(b, h) + aoff + m * 2048 + k * 1024); } while (0)
#define PG8_LDB(dst, b, h) do { _Pragma("unroll") for (int n = 0; n < 2; ++n) _Pragma("unroll") for (int k = 0; k < 2; ++k) dst[n][k] = *(const LAS bf16x8*)(lds + PG8_SB(b, h) + boff + n * 2048 + k * 1024); } while (0)
#define PG8_MMA(ai, bj, At, Bt) do { __builtin_amdgcn_s_setprio(1); _Pragma("unroll") for (int m = 0; m < 4; ++m) _Pragma("unroll") for (int n = 0; n < 2; ++n) _Pragma("unroll") for (int k = 0; k < 2; ++k) \
        acc[ai][bj][m][n] = __builtin_amdgcn_mfma_f32_16x16x32_bf16(Bt[n][k], At[m][k], acc[ai][bj][m][n], 0, 0, 0); __builtin_amdgcn_s_setprio(0); } while (0)
#define PG8_WAIT_V(n) asm volatile("s_waitcnt vmcnt(" #n ")" ::: "memory")
#define PG8_WAIT_L(n) asm volatile("s_waitcnt lgkmcnt(" #n ")" ::: "memory")
#define PG8_BAR __builtin_amdgcn_s_barrier()
#define PG8_SCHED __builtin_amdgcn_sched_barrier(0)
    Unit cur, nxt; int ui = 0;
    if (!S.next(0, cur)) return;
    f32x4 acc[2][2][4][2];
#pragma unroll
    for (int a = 0; a < 2; ++a)
#pragma unroll
        for (int b = 0; b < 2; ++b)
#pragma unroll
            for (int m = 0; m < 4; ++m)
#pragma unroll
                for (int n = 0; n < 2; ++n) acc[a][b][m][n] = (f32x4){0.f, 0.f, 0.f, 0.f};
    bf16x8 At[4][2], B0[2][2], B1[2][2];
    const char* cA = (const char*)g.A + (size_t)cur.pm * tstep; const char* cB = (const char*)g.Bt + (size_t)cur.pn * tstep;
    S.a_ready(cur);
    if constexpr (SP2) {
        PG8_STAGE(PG8_SB(0, 0), cB, voffB); PG8_STAGE(PG8_SB(0, 1), cB + hstep, voffB); PG8_STAGE(PG8_SA(0, 0), cA, voffA); PG8_STAGE(PG8_SA(0, 1), cA + hstep, voffA);
        if (wr == 1) PG8_BAR;
        PG8_WAIT_V(2); PG8_BAR;
        PG8_STAGE(PG8_SB(1, 0), cB + kstep, voffB); PG8_STAGE(PG8_SA(1, 0), cA + kstep, voffA); PG8_STAGE(PG8_SB(1, 1), cB + hstep + kstep, voffB);
        PG8_WAIT_V(6); PG8_BAR;
    } else {
        PG8_STAGE(PG8_SB(0, 0), cB, voffB); PG8_STAGE(PG8_SA(0, 0), cA, voffA); PG8_STAGE(PG8_SB(0, 1), cB + hstep, voffB); PG8_STAGE(PG8_SA(0, 1), cA + hstep, voffA);
        if (wr == 1) PG8_BAR;
        PG8_WAIT_V(4); PG8_BAR;
        PG8_STAGE(PG8_SB(1, 0), cB + kstep, voffB); PG8_STAGE(PG8_SA(1, 0), cA + kstep, voffA); PG8_STAGE(PG8_SB(1, 1), cB + hstep + kstep, voffB);
        PG8_WAIT_V(6); PG8_BAR;
    }
    for (;;) {
        const bool has_next = S.next(ui + 1, nxt);
        const char* nA = has_next ? (const char*)g.A + (size_t)nxt.pm * tstep : cA; const char* nB = has_next ? (const char*)g.Bt + (size_t)nxt.pn * tstep : cB;
        for (int t = 0; t < nt; t += 2) {
            const bool last = (t == nt - 2);
            const char* a1 = cA + (size_t)(t + 1) * kstep;
            const char* a2 = last ? nA : cA + (size_t)(t + 2) * kstep; const char* b2 = last ? nB : cB + (size_t)(t + 2) * kstep;
            const char* a3 = a2 + kstep; const char* b3 = b2 + kstep;
            if (last && has_next) S.a_ready(nxt);
            if constexpr (SP2) {
            PG8_LDB(B0, 0, 0); PG8_LDB(B1, 0, 1); PG8_SCHED; PG8_LDA(At, 0, 0); PG8_STAGE(PG8_SA(1, 1), a1 + hstep, voffA);
            PG8_WAIT_V(8); PG8_WAIT_L(0); PG8_BAR; PG8_MMA(0, 0, At, B0); PG8_MMA(0, 1, At, B1); PG8_BAR; PG8_SCHED;
            PG8_LDA(At, 0, 1); PG8_STAGE(PG8_SB(0, 0), b2, voffB); PG8_STAGE(PG8_SB(0, 1), b2 + hstep, voffB); PG8_STAGE(PG8_SA(0, 0), a2, voffA);
            PG8_WAIT_V(8); PG8_WAIT_L(0); PG8_BAR; PG8_MMA(1, 0, At, B0); PG8_MMA(1, 1, At, B1); PG8_BAR; PG8_SCHED;
            PG8_LDB(B0, 1, 0); PG8_LDB(B1, 1, 1); PG8_SCHED; PG8_LDA(At, 1, 0); PG8_STAGE(PG8_SA(0, 1), a2 + hstep, voffA);
            PG8_WAIT_V(8); PG8_WAIT_L(0); PG8_BAR; PG8_MMA(0, 0, At, B0); PG8_MMA(0, 1, At, B1); PG8_BAR; PG8_SCHED;
            PG8_LDA(At, 1, 1); PG8_STAGE(PG8_SB(1, 0), b3, voffB); PG8_STAGE(PG8_SB(1, 1), b3 + hstep, voffB); PG8_STAGE(PG8_SA(1, 0), a3, voffA);
            PG8_WAIT_V(8); PG8_WAIT_L(0); PG8_BAR; PG8_MMA(1, 0, At, B0); PG8_MMA(1, 1, At, B1); PG8_BAR; PG8_SCHED;
            } else {
            PG8_LDB(B0, 0, 0); PG8_SCHED; PG8_LDA(At, 0, 0); PG8_STAGE(PG8_SA(1, 1), a1 + hstep, voffA);
            PG8_WAIT_L(8); PG8_BAR; PG8_WAIT_L(0); PG8_MMA(0, 0, At, B0); PG8_BAR; PG8_SCHED;
            PG8_LDB(B1, 0, 1); PG8_STAGE(PG8_SB(0, 0), b2, voffB);
            PG8_BAR; PG8_WAIT_L(0); PG8_MMA(0, 1, At, B1); PG8_BAR;
            PG8_LDA(At, 0, 1); PG8_STAGE(PG8_SA(0, 0), a2, voffA);
            PG8_BAR; PG8_WAIT_L(0); PG8_MMA(1, 0, At, B0); PG8_BAR; PG8_SCHED;
            PG8_STAGE(PG8_SB(0, 1), b2 + hstep, voffB);
            PG8_WAIT_V(6); PG8_BAR; PG8_MMA(1, 1, At, B1); PG8_BAR;
            PG8_LDB(B0, 1, 0); PG8_SCHED; PG8_LDA(At, 1, 0); PG8_STAGE(PG8_SA(0, 1), a2 + hstep, voffA);
            PG8_WAIT_L(8); PG8_BAR; PG8_WAIT_L(0); PG8_MMA(0, 0, At, B0); PG8_BAR; PG8_SCHED;
            PG8_LDB(B1, 1, 1); PG8_STAGE(PG8_SB(1, 0), b3, voffB);
            PG8_BAR; PG8_WAIT_L(0); PG8_MMA(0, 1, At, B1); PG8_BAR;
            PG8_LDA(At, 1, 1); PG8_STAGE(PG8_SA(1, 0), a3, voffA);
            PG8_BAR; PG8_WAIT_L(0); PG8_MMA(1, 0, At, B0); PG8_BAR; PG8_SCHED;
            PG8_STAGE(PG8_SB(1, 1), b3 + hstep, voffB);
            PG8_WAIT_V(6); PG8_BAR; PG8_MMA(1, 1, At, B1); PG8_BAR;
            }
        }
        if constexpr (ALIGN_EPI) { if (wr == 0) PG8_BAR; }
        E(acc, cur, wr, wc, fr, fq);
        if (!has_next) break;
#pragma unroll
        for (int a = 0; a < 2; ++a)
#pragma unroll
            for (int b = 0; b < 2; ++b)
#pragma unroll
                for (int m = 0; m < 4; ++m)
#pragma unroll
                    for (int n = 0; n < 2; ++n) acc[a][b][m][n] = (f32x4){0.f, 0.f, 0.f, 0.f};
        cur = nxt; cA = nA; cB = nB; ++ui;
        if constexpr (ALIGN_EPI) { if (wr == 1) PG8_BAR; }
    }
    PG8_WAIT_V(0);
    if constexpr (!ALIGN_EPI) { if (wr == 0) PG8_BAR; }
    PG8_BAR;
#undef PG8_SA
#undef PG8_SB
#undef PG8_STAGE
#undef PG8_LDA
#undef PG8_LDB
#undef PG8_MMA
#undef PG8_WAIT_V
#undef PG8_WAIT_L
#undef PG8_BAR
#undef PG8_SCHED
}
}

constexpr int DM = 1024, TG = 32768, NGROUPS = 3, DFF = 4096;
constexpr int N1A = 2560, N1B = 3072, NQ = 768, NKV = 1024;
constexpr float EPS = 1e-6f;
constexpr float LOG2E = 1.4426950408889634f;
constexpr float QSCALE = 0.10206207261596575f * LOG2E;
constexpr float LOG2_THETA = 13.287712379549449f;
constexpr float INV_2PI = 0.15915494309189535f;

constexpr size_t MiB = 1u << 20;
constexpr size_t WS_SSQ = 0;
constexpr size_t WS_BAR = 1792 * 1024;
constexpr size_t WS_W1A = 2 * MiB;
constexpr size_t WS_W1B = 7 * MiB;
constexpr size_t WS_WQ = 13 * MiB;
constexpr size_t WS_WKV = 13 * MiB + 512 * 1024;
constexpr size_t WS_WA = 14 * MiB;
constexpr size_t WS_WB = 15 * MiB;
constexpr size_t WS_WO = 17 * MiB;
constexpr size_t WS_WU = 19 * MiB;
constexpr size_t WS_WD = 27 * MiB;
constexpr size_t WS_ACT = 40 * MiB;
constexpr size_t A_HBF = WS_ACT + 0 * MiB, A_CQ = WS_ACT + 64 * MiB, A_CKV = WS_ACT + 80 * MiB, A_KR = WS_ACT + 88 * MiB;
constexpr size_t A_RQ = WS_ACT + 96 * MiB, A_RK = WS_ACT + 128 * MiB, A_RVT = WS_ACT + 160 * MiB, A_QN = WS_ACT + 224 * MiB;
constexpr size_t A_QR = WS_ACT + 256 * MiB, A_KN = WS_ACT + 272 * MiB, A_VT = WS_ACT + 304 * MiB, A_ST = WS_ACT + 336 * MiB;
constexpr size_t A_G3 = WS_ACT + 400 * MiB;
constexpr size_t A_OB = WS_ACT + 592 * MiB, A_MA = WS_ACT + 656 * MiB, A_MG = WS_ACT + 784 * MiB;
constexpr size_t A_MF = WS_ACT + 0 * MiB, A_H2 = WS_ACT + 128 * MiB, A_U = WS_ACT + 192 * MiB, A_DF = WS_ACT + 448 * MiB;
constexpr size_t A_X1 = WS_ACT + 512 * MiB;
constexpr size_t WS_NEED = WS_ACT + 848 * MiB;

constexpr int LDS_BYTES = 155648;
constexpr int LDS_TSCR = 131328, TS_P = 80;

__device__ __forceinline__ float bf_lo(unsigned u) { return __uint_as_float(u << 16); }
__device__ __forceinline__ float bf_hi(unsigned u) { return __uint_as_float(u & 0xffff0000u); }
__device__ __forceinline__ bf16_t f2bf(float f) { return (bf16_t)(pg8::cvt_pk_bf16(f, f) & 0xffffu); }
__device__ __forceinline__ float wave_sum(float v) {
#pragma unroll
    for (int o = 1; o < 64; o <<= 1) v += __shfl_xor(v, o);
    return v;
}
__device__ __forceinline__ float fast_exp2(float x) { return __builtin_amdgcn_exp2f(x); }
__device__ __forceinline__ float sigmoidf_(float v) { return __builtin_amdgcn_rcpf(1.0f + fast_exp2(-v * LOG2E)); }
__device__ __forceinline__ void sincos_rev(float pos, float invf, float& s, float& c) {
    const float ang = pos * invf; const float fr = __builtin_amdgcn_fractf(ang * INV_2PI);
    s = __builtin_amdgcn_sinf(fr); c = __builtin_amdgcn_cosf(fr);
}
__device__ __forceinline__ void atomic_addf(float* p, float v) { __hip_atomic_fetch_add(p, v, __ATOMIC_RELAXED, __HIP_MEMORY_SCOPE_AGENT); }
__device__ __forceinline__ u32x4 pack8(const f32x4& a, const f32x4& b) {
    u32x4 w; w.x = pg8::cvt_pk_bf16(a[0], a[1]); w.y = pg8::cvt_pk_bf16(a[2], a[3]); w.z = pg8::cvt_pk_bf16(b[0], b[1]); w.w = pg8::cvt_pk_bf16(b[2], b[3]); return w;
}

typedef f32x4 AccT[2][2][4][2];
template <class T> __device__ __forceinline__ T* at(const void* base, unsigned byteoff) { return (T*)((char*)base + byteoff); }

struct Epi1 {
    static constexpr bool PERM = true;
    bf16_t *CQ, *CKV, *KR, *RQ, *RK, *RVT; float *ssq_q, *ssq_kv; int slog; LAS unsigned char* tscr;
    __device__ __forceinline__ void operator()(const AccT& acc, const pg8::Unit& u, int wr, int wc, int fr, int fq) const {
        asm volatile("" : "+v"(fr), "+v"(fq), "+s"(wr), "+s"(wc));
        const int pn = u.pn, S = 1 << slog; const int rowb = u.pm * 256 + wr * 64 + fr;
        if (pn == 0) {
#pragma unroll
            for (int ai = 0; ai < 2; ++ai)
#pragma unroll
                for (int m = 0; m < 4; ++m) { const int row = rowb + ai * 128 + m * 16; float s = 0.f;
#pragma unroll
                    for (int bj = 0; bj < 2; ++bj) { const f32x4 v0 = acc[ai][bj][m][0], v1 = acc[ai][bj][m][1];
                        s += (v0[0] * v0[0] + v0[1] * v0[1]) + (v0[2] * v0[2] + v0[3] * v0[3]) + (v1[0] * v1[0] + v1[1] * v1[1]) + (v1[2] * v1[2] + v1[3] * v1[3]);
                        *at<u32x4>(CQ, 2u * (unsigned)(row * 256 + bj * 128 + wc * 32 + 8 * fq)) = pack8(v0, v1); }
                    s += __shfl_xor(s, 16); s += __shfl_xor(s, 32);
                    if (fq == 0) atomic_addf(at<float>(ssq_q, 4u * (unsigned)row), s); }
        } else if (pn == 1) {
            float invf[4];
#pragma unroll
            for (int j = 0; j < 4; ++j) invf[j] = fast_exp2(-(float)(4 * fq + j) * (LOG2_THETA / 16.0f));
#pragma unroll
            for (int ai = 0; ai < 2; ++ai)
#pragma unroll
                for (int m = 0; m < 4; ++m) { const int row = rowb + ai * 128 + m * 16;
                    { const f32x4 v0 = acc[ai][0][m][0], v1 = acc[ai][0][m][1];
                      float s = (v0[0] * v0[0] + v0[1] * v0[1]) + (v0[2] * v0[2] + v0[3] * v0[3]) + (v1[0] * v1[0] + v1[1] * v1[1]) + (v1[2] * v1[2] + v1[3] * v1[3]);
                      *at<u32x4>(CKV, 2u * (unsigned)(row * 128 + wc * 32 + 8 * fq)) = pack8(v0, v1);
                      s += __shfl_xor(s, 16); s += __shfl_xor(s, 32);
                      if (fq == 0) atomic_addf(at<float>(ssq_kv, 4u * (unsigned)row), s); }
                    if (wc == 0) { const f32x4 x1 = acc[ai][1][m][0], x2 = acc[ai][1][m][1]; const float pos = (float)(row & (S - 1)); f32x4 o1, o2;
#pragma unroll
                        for (int j = 0; j < 4; ++j) { float sn, cs; sincos_rev(pos, invf[j], sn, cs); o1[j] = x1[j] * cs - x2[j] * sn; o2[j] = x1[j] * sn + x2[j] * cs; }
                        *at<u32x4>(KR, 2u * (unsigned)(row * 32 + 8 * fq)) = pack8(o1, o2); } }
        } else if (pn <= 5) {
            const bool isk = pn >= 4; bf16_t* dst = isk ? RK : RQ; const float sc = isk ? 0.125f : 1.0f; const int colt = (pn & 1) * 256;
            const int g = (wc & 1) * 4 + fq; float invf[4];
#pragma unroll
            for (int j = 0; j < 4; ++j) invf[j] = fast_exp2(-(float)(4 * g + j) * (LOG2_THETA / 32.0f));
#pragma unroll
            for (int ai = 0; ai < 2; ++ai)
#pragma unroll
                for (int m = 0; m < 4; ++m) { const int row = rowb + ai * 128 + m * 16; const float pos = (float)(row & (S - 1)); float sn[4], cs[4];
#pragma unroll
                    for (int j = 0; j < 4; ++j) sincos_rev(pos, invf[j], sn[j], cs[j]);
#pragma unroll
                    for (int bj = 0; bj < 2; ++bj) { const f32x4 x1 = acc[ai][bj][m][0], x2 = acc[ai][bj][m][1]; f32x4 o1, o2;
#pragma unroll
                        for (int j = 0; j < 4; ++j) { o1[j] = (x1[j] * cs[j] - x2[j] * sn[j]) * sc; o2[j] = (x1[j] * sn[j] + x2[j] * cs[j]) * sc; }
                        *at<u32x4>(dst, 2u * (unsigned)(row * 512 + colt + bj * 128 + wc * 32 + 8 * fq)) = pack8(o1, o2); } }
        } else {
            LAS unsigned char* tl = tscr + (wr * 4 + wc) * (32 * TS_P); const int lane = fq * 16 + fr, rdv = lane >> 1, rh = lane & 1;
#pragma unroll
            for (int ai = 0; ai < 2; ++ai)
#pragma unroll
                for (int mp = 0; mp < 2; ++mp)
#pragma unroll
                    for (int bj = 0; bj < 2; ++bj) {
#pragma unroll
                        for (int mm = 0; mm < 2; ++mm) { const int p = 8 * (fr >> 2) + 4 * mm + (fr & 3);
#pragma unroll
                            for (int n = 0; n < 2; ++n)
#pragma unroll
                                for (int j = 0; j < 4; ++j) *(LAS bf16_t*)(tl + (8 * fq + 4 * n + j) * TS_P + 2 * p) = f2bf(acc[ai][bj][2 * mp + mm][n][j]); }
                        const u32x4 q0 = *(const LAS u32x4*)(tl + rdv * TS_P + 32 * rh), q1 = *(const LAS u32x4*)(tl + rdv * TS_P + 32 * rh + 16);
                        const int tokb = u.pm * 256 + ai * 128 + wr * 64 + 32 * mp; const int seq = tokb >> slog, posb = tokb & (S - 1);
                        const int colb = (pn - 6) * 256 + bj * 128 + wc * 32; const int head = colb >> 7, dvh = colb & 127;
                        const unsigned gb = 2u * (unsigned)(((seq * 8 + head) * 128 + dvh + rdv) * S + posb + 16 * rh);
                        *at<u32x4>(RVT, gb) = q0; *at<u32x4>(RVT, gb + 16u) = q1; }
        }
    }
};

struct Epi2q {
    static constexpr bool PERM = true;
    bf16_t *QN, *QR; const float* ssq_q; int slog;
    __device__ __forceinline__ void operator()(const AccT& acc, const pg8::Unit& u, int wr, int wc, int fr, int fq) const {
        asm volatile("" : "+v"(fr), "+v"(fq), "+s"(wr), "+s"(wc));
        const int pn = u.pn, S = 1 << slog; const int rowb = u.pm * 256 + wr * 64 + fr;
        float invf[4];
#pragma unroll
        for (int j = 0; j < 4; ++j) invf[j] = fast_exp2(-(float)(4 * fq + j) * (LOG2_THETA / 16.0f));
#pragma unroll
        for (int ai = 0; ai < 2; ++ai)
#pragma unroll
            for (int m = 0; m < 4; ++m) { const int row = rowb + ai * 128 + m * 16; const float f = rsqrtf(*at<const float>(ssq_q, 4u * (unsigned)row) * (1.0f / 256.0f) + EPS) * QSCALE;
                if (pn < 2) {
#pragma unroll
                    for (int bj = 0; bj < 2; ++bj) *at<u32x4>(QN, 2u * (unsigned)(row * 512 + pn * 256 + bj * 128 + wc * 32 + 8 * fq)) = pack8(acc[ai][bj][m][0] * f, acc[ai][bj][m][1] * f);
                } else { const float pos = (float)(row & (S - 1)); float sn[4], cs[4];
#pragma unroll
                    for (int j = 0; j < 4; ++j) sincos_rev(pos, invf[j], sn[j], cs[j]);
#pragma unroll
                    for (int bj = 0; bj < 2; ++bj) { const f32x4 x1 = acc[ai][bj][m][0], x2 = acc[ai][bj][m][1]; f32x4 o1, o2;
#pragma unroll
                        for (int j = 0; j < 4; ++j) { o1[j] = (x1[j] * cs[j] - x2[j] * sn[j]) * f; o2[j] = (x1[j] * sn[j] + x2[j] * cs[j]) * f; }
                        *at<u32x4>(QR, 2u * (unsigned)(row * 256 + bj * 128 + wc * 32 + 8 * fq)) = pack8(o1, o2); } } }
    }
};

struct Epi2kv {
    static constexpr bool PERM = true;
    bf16_t *KN, *VT; const float* ssq_kv; int slog; LAS unsigned char* tscr;
    __device__ __forceinline__ void operator()(const AccT& acc, const pg8::Unit& u, int wr, int wc, int fr, int fq) const {
        asm volatile("" : "+v"(fr), "+v"(fq), "+s"(wr), "+s"(wc));
        const int pn = u.pn, S = 1 << slog; const int rowb = u.pm * 256 + wr * 64 + fr;
        if (pn < 2) {
#pragma unroll
            for (int ai = 0; ai < 2; ++ai)
#pragma unroll
                for (int m = 0; m < 4; ++m) { const int row = rowb + ai * 128 + m * 16; const float f = rsqrtf(*at<const float>(ssq_kv, 4u * (unsigned)row) * (1.0f / 128.0f) + EPS);
#pragma unroll
                    for (int bj = 0; bj < 2; ++bj) *at<u32x4>(KN, 2u * (unsigned)(row * 512 + pn * 256 + bj * 128 + wc * 32 + 8 * fq)) = pack8(acc[ai][bj][m][0] * f, acc[ai][bj][m][1] * f); }
        } else {
            LAS unsigned char* tl = tscr + (wr * 4 + wc) * (32 * TS_P); const int lane = fq * 16 + fr, rdv = lane >> 1, rh = lane & 1;
            const int p16 = 8 * ((fr >> 2) & 1) + 4 * (fr >> 3) + (fr & 3);
#pragma unroll
            for (int ai = 0; ai < 2; ++ai)
#pragma unroll
                for (int mp = 0; mp < 2; ++mp) {
                    float f[2];
#pragma unroll
                    for (int mm = 0; mm < 2; ++mm) f[mm] = rsqrtf(*at<const float>(ssq_kv, 4u * (unsigned)(rowb + ai * 128 + (2 * mp + mm) * 16)) * (1.0f / 128.0f) + EPS);
#pragma unroll
                    for (int bj = 0; bj < 2; ++bj) {
#pragma unroll
                        for (int mm = 0; mm < 2; ++mm) { const int p = 16 * mm + p16;
#pragma unroll
                            for (int n = 0; n < 2; ++n)
#pragma unroll
                                for (int j = 0; j < 4; ++j) *(LAS bf16_t*)(tl + (8 * fq + 4 * n + j) * TS_P + 2 * p) = f2bf(acc[ai][bj][2 * mp + mm][n][j] * f[mm]); }
                        const u32x4 q0 = *(const LAS u32x4*)(tl + rdv * TS_P + 32 * rh), q1 = *(const LAS u32x4*)(tl + rdv * TS_P + 32 * rh + 16);
                        const int tokb = u.pm * 256 + ai * 128 + wr * 64 + 32 * mp; const int seq = tokb >> slog, posb = tokb & (S - 1);
                        const int colb = (pn - 2) * 256 + bj * 128 + wc * 32; const int head = colb >> 6, dvh = colb & 63;
                        const unsigned gb = 2u * (unsigned)(((seq * 8 + head) * 64 + dvh + rdv) * S + posb + 16 * rh);
                        *at<u32x4>(VT, gb) = q0; *at<u32x4>(VT, gb + 16u) = q1; } }
        }
    }
};

template <int ACT> struct EpiAct {
    static constexpr bool PERM = true;
    bf16_t* O; int ldc; const float* rs2;
    __device__ __forceinline__ void operator()(const AccT& acc, const pg8::Unit& u, int wr, int wc, int fr, int fq) const {
        asm volatile("" : "+v"(fr), "+v"(fq), "+s"(wr), "+s"(wc));
        const int rowb = u.pm * 256 + wr * 64 + fr; int colt = u.pn * 256; unsigned boff = 0u; bool silu = false;
        if (ACT == 1) { const int t = u.pn >> 2; boff = (unsigned)t * (unsigned)(TG * 1024 * 2); colt = (u.pn & 3) * 256; silu = (t == 0); }
#pragma unroll
        for (int ai = 0; ai < 2; ++ai)
#pragma unroll
            for (int m = 0; m < 4; ++m) { const int row = rowb + ai * 128 + m * 16; float rsq = 1.0f; if (ACT == 2) rsq = *at<const float>(rs2, 4u * (unsigned)row);
#pragma unroll
                for (int bj = 0; bj < 2; ++bj) { f32x4 v[2] = {acc[ai][bj][m][0], acc[ai][bj][m][1]};
#pragma unroll
                    for (int n = 0; n < 2; ++n)
#pragma unroll
                        for (int j = 0; j < 4; ++j) { const float x = v[n][j];
                            if (ACT == 1) { const float sg = sigmoidf_(x); v[n][j] = silu ? x * sg : sg; }
                            else { const float r = fmaxf(x, 0.f); v[n][j] = r * r * rsq; } }
                    *at<u32x4>(O, boff + 2u * (unsigned)(row * ldc + colt + bj * 128 + wc * 32 + 8 * fq)) = pack8(v[0], v[1]); } }
    }
};

struct Epi4 {
    static constexpr bool PERM = true;
    const bf16_t* SGA; bf16_t* MA;
    __device__ __forceinline__ void operator()(const AccT& acc, const pg8::Unit& u, int wr, int wc, int fr, int fq) const {
        asm volatile("" : "+v"(fr), "+v"(fq), "+s"(wr), "+s"(wc));
        const int rowb = u.pm * 256 + wr * 64 + fr;
#pragma unroll
        for (int ai = 0; ai < 2; ++ai)
#pragma unroll
            for (int m = 0; m < 4; ++m) { const int row = rowb + ai * 128 + m * 16;
#pragma unroll
                for (int bj = 0; bj < 2; ++bj) { const unsigned off = (unsigned)(row * 1024 + u.pn * 256 + bj * 128 + wc * 32 + 8 * fq);
                    const u32x4 gq = *at<const u32x4>(SGA, 2u * off); const f32x4 a0 = acc[ai][bj][m][0], a1 = acc[ai][bj][m][1];
                    f32x4 o0, o1; o0[0] = a0[0] * bf_lo(gq.x); o0[1] = a0[1] * bf_hi(gq.x); o0[2] = a0[2] * bf_lo(gq.y); o0[3] = a0[3] * bf_hi(gq.y);
                    o1[0] = a1[0] * bf_lo(gq.z); o1[1] = a1[1] * bf_hi(gq.z); o1[2] = a1[2] * bf_lo(gq.w); o1[3] = a1[3] * bf_hi(gq.w);
                    *at<u32x4>(MA, 2u * off) = pack8(o0, o1); } }
    }
};
struct Epi5 {
    static constexpr bool PERM = true;
    const bf16_t* SGB; const bf16_t* MA; bf16_t* MG;
    __device__ __forceinline__ void operator()(const AccT& acc, const pg8::Unit& u, int wr, int wc, int fr, int fq) const {
        asm volatile("" : "+v"(fr), "+v"(fq), "+s"(wr), "+s"(wc));
        const int rowb = u.pm * 256 + wr * 64 + fr;
#pragma unroll
        for (int ai = 0; ai < 2; ++ai)
#pragma unroll
            for (int m = 0; m < 4; ++m) { const int row = rowb + ai * 128 + m * 16;
#pragma unroll
                for (int bj = 0; bj < 2; ++bj) { const unsigned off = (unsigned)(row * 1024 + u.pn * 256 + bj * 128 + wc * 32 + 8 * fq);
                    const u32x4 gq = *at<const u32x4>(SGB, 2u * off); const f32x4 a0 = acc[ai][bj][m][0], a1 = acc[ai][bj][m][1];
                    const u32x4 mq = *at<const u32x4>(MA, 2u * off); f32x4 o0 = (f32x4){bf_lo(mq.x), bf_hi(mq.x), bf_lo(mq.y), bf_hi(mq.y)}, o1 = (f32x4){bf_lo(mq.z), bf_hi(mq.z), bf_lo(mq.w), bf_hi(mq.w)};
                    o0[0] += a0[0] * bf_lo(gq.x); o0[1] += a0[1] * bf_hi(gq.x); o0[2] += a0[2] * bf_lo(gq.y); o0[3] += a0[3] * bf_hi(gq.y);
                    o1[0] += a1[0] * bf_lo(gq.z); o1[1] += a1[1] * bf_hi(gq.z); o1[2] += a1[2] * bf_lo(gq.w); o1[3] += a1[3] * bf_hi(gq.w);
                    *at<u32x4>(MG, 2u * off) = pack8(o0, o1); } }
    }
};
struct EpiF32Ssq {
    static constexpr bool PERM = true;
    bf16_t* O; float* ssq;
    __device__ __forceinline__ void operator()(const AccT& acc, const pg8::Unit& u, int wr, int wc, int fr, int fq) const {
        asm volatile("" : "+v"(fr), "+v"(fq), "+s"(wr), "+s"(wc));
        const int rowb = u.pm * 256 + wr * 64 + fr;
#pragma unroll
        for (int ai = 0; ai < 2; ++ai)
#pragma unroll
            for (int m = 0; m < 4; ++m) { const int row = rowb + ai * 128 + m * 16; float s = 0.f;
#pragma unroll
                for (int bj = 0; bj < 2; ++bj) { const unsigned off = (unsigned)(row * 1024 + u.pn * 256 + bj * 128 + wc * 32 + 8 * fq); const f32x4 v0 = acc[ai][bj][m][0], v1 = acc[ai][bj][m][1];
                    s += (v0[0] * v0[0] + v0[1] * v0[1]) + (v0[2] * v0[2] + v0[3] * v0[3]) + (v1[0] * v1[0] + v1[1] * v1[1]) + (v1[2] * v1[2] + v1[3] * v1[3]);
                    *at<u32x4>(O, 2u * off) = pack8(v0, v1); }
                s += __shfl_xor(s, 16); s += __shfl_xor(s, 32);
                if (fq == 0) atomic_addf(at<float>(ssq, 4u * (unsigned)row), s); }
    }
};

struct Args {
    const float* x_prompt; const float* x_sample; const float* g_pre_mix; const float* w_in; const float* g_q_norm; const float* w_q_up;
    const float* g_kv_norm; const float* w_kv_up; const float* w_branch_a; const float* ldf; const float* ldb; const float* w_branch_b;
    const float* w_out; const float* g_post_mix; const float* g_pre_mlp; const float* w_up; const float* w_down; const float* g_post_mlp;
    float* out; unsigned char* ws;
};

__device__ __forceinline__ int src_col(int mode, int n, int coff) {
    if (mode == 0) return coff + n;
    if (mode == 1) {
        if (n < 256) return n;
        if (n < 384) return n;
        if (n < 416) { const int c = n - 384; return 384 + 16 * ((c >> 2) & 1) + 4 * (c >> 3) + (c & 3); }
        if (n < 512) return -1;
        if (n < 1536) { const int c = (n - 512) & 511, base = (n < 1024) ? 416 : 928; const int head = c >> 6, w = c & 63; return base + 64 * head + 32 * ((w >> 2) & 1) + 4 * (w >> 3) + (w & 3); }
        return 1440 + (n - 1536);
    }
    if (mode == 2) {
        if (n < 512) return 96 * (n >> 6) + (n & 63);
        const int c = n - 512, head = c >> 5, w = c & 31; return 96 * head + 64 + 16 * ((w >> 2) & 1) + 4 * (w >> 3) + (w & 3);
    }
    if (n < 512) return 128 * (n >> 6) + (n & 63);
    { const int c = n - 512; return 128 * (c >> 6) + 64 + (c & 63); }
}
struct CW { const float* W; int ldw, K, Nout, mode, coff; const float* gk; bf16_t* out; };
__device__ __forceinline__ void convert_item(const CW& c, int it) {
    const int n = it % c.Nout, kb = (it / c.Nout) * 64; const int sc = src_col(c.mode, n, c.coff);
#pragma unroll 2
    for (int sub = 0; sub < 8; ++sub) { const int k0 = kb + 8 * sub;
        float v[8];
#pragma unroll
        for (int e = 0; e < 8; ++e) { float x = (sc >= 0) ? c.W[(size_t)(k0 + e) * c.ldw + sc] : 0.f; if (c.gk) x *= c.gk[k0 + e]; v[e] = x; }
        u32x4 w; w.x = pg8::cvt_pk_bf16(v[0], v[1]); w.y = pg8::cvt_pk_bf16(v[2], v[3]); w.z = pg8::cvt_pk_bf16(v[4], v[5]); w.w = pg8::cvt_pk_bf16(v[6], v[7]);
        *(u32x4*)(c.out + (size_t)n * c.K + k0) = w; }
}

__device__ __forceinline__ float ssq4(const f32x4& v) { return (v[0] * v[0] + v[1] * v[1]) + (v[2] * v[2] + v[3] * v[3]); }
__device__ __forceinline__ u32x2 pk4(const f32x4& y) { u32x2 w; w.x = pg8::cvt_pk_bf16(y[0], y[1]); w.y = pg8::cvt_pk_bf16(y[2], y[3]); return w; }
__device__ __forceinline__ f32x4 unpk4(const u32x2& w) { return (f32x4){bf_lo(w.x), bf_hi(w.x), bf_lo(w.y), bf_hi(w.y)}; }
constexpr int RP_NR = 2;
__device__ __forceinline__ void rowpass0(const float* x, const float* g, bf16_t* HBF, int gw, int ngw, int lane) {
    f32x4 gv[4];
#pragma unroll
    for (int j = 0; j < 4; ++j) gv[j] = ((const f32x4*)g)[64 * j + lane];
    for (int r = gw; r < TG; r += RP_NR * ngw) {
        f32x4 v[RP_NR][4]; int rr[RP_NR];
#pragma unroll
        for (int k = 0; k < RP_NR; ++k) { rr[k] = (r + k * ngw < TG) ? r + k * ngw : r; const f32x4* xr = (const f32x4*)(x + (size_t)rr[k] * DM) + lane;
#pragma unroll
            for (int j = 0; j < 4; ++j) v[k][j] = __builtin_nontemporal_load(xr + 64 * j); }
#pragma unroll
        for (int k = 0; k < RP_NR; ++k) { float s = 0.f;
#pragma unroll
            for (int j = 0; j < 4; ++j) s += ssq4(v[k][j]);
            const float rs = rsqrtf(wave_sum(s) * (1.0f / DM) + EPS); u32x2* o = (u32x2*)(HBF + (size_t)rr[k] * DM) + lane;
#pragma unroll
            for (int j = 0; j < 4; ++j) o[64 * j] = pk4(v[k][j] * rs * gv[j]); }
    }
}
__device__ __forceinline__ void rowpass1(const float* x, const bf16_t* MF, const float* ssq_m, const float* g1, bf16_t* X1, float* rs2, int gw, int ngw, int lane) {
    f32x4 g1v[4];
#pragma unroll
    for (int j = 0; j < 4; ++j) g1v[j] = ((const f32x4*)g1)[64 * j + lane];
    for (int r = gw; r < TG; r += RP_NR * ngw) {
        f32x4 v[RP_NR][4]; u32x2 wv[RP_NR][4]; int rr[RP_NR]; float rm[RP_NR];
#pragma unroll
        for (int k = 0; k < RP_NR; ++k) { rr[k] = (r + k * ngw < TG) ? r + k * ngw : r; const f32x4* xr = (const f32x4*)(x + (size_t)rr[k] * DM) + lane; const u32x2* mr = (const u32x2*)(MF + (size_t)rr[k] * DM) + lane;
            rm[k] = ssq_m[rr[k]];
#pragma unroll
            for (int j = 0; j < 4; ++j) { v[k][j] = __builtin_nontemporal_load(xr + 64 * j); wv[k][j] = __builtin_nontemporal_load(mr + 64 * j); } }
#pragma unroll
        for (int k = 0; k < RP_NR; ++k) { const float rmk = rsqrtf(rm[k] * (1.0f / DM) + EPS); float s = 0.f;
#pragma unroll
            for (int j = 0; j < 4; ++j) { v[k][j] = v[k][j] + unpk4(wv[k][j]) * rmk * g1v[j]; s += ssq4(v[k][j]); }
            const float rs = rsqrtf(wave_sum(s) * (1.0f / DM) + EPS);
            u32x2* orow = (u32x2*)(X1 + (size_t)rr[k] * DM) + lane; if (lane == 0) rs2[rr[k]] = rs * rs;
#pragma unroll
            for (int j = 0; j < 4; ++j) orow[64 * j] = pk4(v[k][j]); }
    }
}
__device__ __forceinline__ void rowpass2(const bf16_t* X1, const bf16_t* DF, const float* ssq_d, const float* g3, float* out, int gw, int ngw, int lane) {
    f32x4 g3v[4];
#pragma unroll
    for (int j = 0; j < 4; ++j) g3v[j] = ((const f32x4*)g3)[64 * j + lane];
    for (int r = gw; r < TG; r += RP_NR * ngw) {
        u32x2 xv[RP_NR][4]; u32x2 wv[RP_NR][4]; int rr[RP_NR]; float rd[RP_NR];
#pragma unroll
        for (int k = 0; k < RP_NR; ++k) { rr[k] = (r + k * ngw < TG) ? r + k * ngw : r; const u32x2* xr = (const u32x2*)(X1 + (size_t)rr[k] * DM) + lane; const u32x2* dr = (const u32x2*)(DF + (size_t)rr[k] * DM) + lane;
            rd[k] = ssq_d[rr[k]];
#pragma unroll
            for (int j = 0; j < 4; ++j) { xv[k][j] = __builtin_nontemporal_load(xr + 64 * j); wv[k][j] = __builtin_nontemporal_load(dr + 64 * j); } }
        asm volatile("" ::: "memory");
#pragma unroll
        for (int k = 0; k < RP_NR; ++k) { const float rdk = rsqrtf(rd[k] * (1.0f / DM) + EPS); f32x4* orow = (f32x4*)(out + (size_t)rr[k] * DM) + lane;
#pragma unroll
            for (int j = 0; j < 4; ++j) __builtin_nontemporal_store(unpk4(xv[k][j]) + unpk4(wv[k][j]) * rdk * g3v[j], orow + 64 * j); }
    }
}

#define LDS_BARRIER() asm volatile("s_waitcnt lgkmcnt(0)\n\ts_barrier" ::: "memory")
__device__ __forceinline__ void gload16_async(u32x4& r, const void* base, unsigned off) { r = *at<const u32x4>(base, off); }
#define VM_WAIT_N(n) asm volatile("s_waitcnt vmcnt(" #n ")" ::: "memory")
constexpr int AT_KP = 208, AT_VP = 144, AT_KB = 64 * AT_KP, AT_VB = 64 * AT_VP, AT_STAGE = AT_KB + AT_VB;
__device__ __forceinline__ void attn_phase(LAS unsigned char* lds, bf16_t* QN, bf16_t* OUT, const bf16_t* QR, const bf16_t* KN, const bf16_t* KR, const bf16_t* VT, int slog, int nseq, int vcu, int G) {
    int tid_ = threadIdx.x; asm volatile("" : "+v"(tid_));
    const int tid = tid_, w = __builtin_amdgcn_readfirstlane(tid >> 6), grp = w >> 2, lane = tid & 63, qi = lane & 31, hi = lane >> 5;
    const int S = 1 << slog, nqb = S >> 8, nunits = nseq * 8 * nqb, ntile = S >> 6;
    const int lk_row = tid >> 3, lk_c = tid & 7;
    const int lr_row = (tid & 255) >> 2, lr_c = tid & 3;
    const int lv_row = tid >> 3, lv_c = tid & 7;
    if (grp == 1) __builtin_amdgcn_s_setprio(1);
    for (int un = vcu; un < nunits; un += G) {
        const int qb = un % nqb, sh = un / nqb, h = sh & 7, seq = sh >> 3;
        const unsigned tokq = (unsigned)(seq * S + qb * 256 + w * 32 + qi);
        bf16x8 Qf[6];
#pragma unroll
        for (int s = 0; s < 4; ++s) Qf[s] = *at<const bf16x8>(QN, 2u * (tokq * 512u + (unsigned)(64 * h + 16 * s + 8 * hi)));
#pragma unroll
        for (int s = 0; s < 2; ++s) Qf[4 + s] = *at<const bf16x8>(QR, 2u * (tokq * 256u + (unsigned)(32 * h + 16 * s + 8 * hi)));
        f32x16 o0, o1, negm, p0, p1;
#pragma unroll
        for (int i = 0; i < 16; ++i) { o0[i] = 0.f; o1[i] = 0.f; negm[i] = 0.f; p0[i] = 0.f; p1[i] = 0.f; }
        float lsum = 0.f;
        const unsigned kn_off = 2u * (unsigned)((seq * S + lk_row) * 512 + 64 * h + 8 * lk_c);
        const unsigned kr_off = 2u * (unsigned)((seq * S + lr_row) * 32 + 8 * lr_c);
        const unsigned vt_off = 2u * (unsigned)(((seq * 8 + h) * 64 + lv_row) * S + 8 * lv_c);
        u32x4 rk = (u32x4){0u, 0u, 0u, 0u}, rr = rk, rv = rk, rk2 = rk, rr2 = rk, rv2 = rk;
        gload16_async(rk, KN, kn_off); gload16_async(rr, KR, kr_off); gload16_async(rv, VT, vt_off);
        VM_WAIT_N(0);
        LDS_BARRIER();
        *(LAS u32x4*)(lds + lk_row * AT_KP + 16 * lk_c) = rk;
        *(LAS u32x4*)(lds + AT_KB + lv_row * AT_VP + 16 * lv_c) = rv;
        if (tid < 256) *(LAS u32x4*)(lds + lr_row * AT_KP + 128 + 16 * lr_c) = rr;
        gload16_async(rk, KN, kn_off + 65536u); gload16_async(rr, KR, kr_off + 4096u); gload16_async(rv, VT, vt_off + 128u);
        gload16_async(rk2, KN, kn_off + 2u * 65536u); gload16_async(rr2, KR, kr_off + 2u * 4096u); gload16_async(rv2, VT, vt_off + 2u * 128u);
        LDS_BARRIER();
#define AT_H1(T) do { LAS unsigned char* Ks = lds + ((T) & 1) * AT_STAGE; \
            bf16x8 kf[6], kg[6]; \
            _Pragma("unroll") for (int s = 0; s < 3; ++s) { kf[2 * s] = *(const LAS bf16x8*)(Ks + qi * AT_KP + 32 * s + 16 * hi); kf[2 * s + 1] = *(const LAS bf16x8*)(Ks + (32 + qi) * AT_KP + 32 * s + 16 * hi); } \
            __builtin_amdgcn_sched_barrier(0); \
            _Pragma("unroll") for (int s = 3; s < 6; ++s) { kg[2 * (s - 3)] = *(const LAS bf16x8*)(Ks + qi * AT_KP + 32 * s + 16 * hi); kg[2 * (s - 3) + 1] = *(const LAS bf16x8*)(Ks + (32 + qi) * AT_KP + 32 * s + 16 * hi); } \
            p0 = __builtin_amdgcn_mfma_f32_32x32x16_bf16(kf[0], Qf[0], negm, 0, 0, 0); p1 = __builtin_amdgcn_mfma_f32_32x32x16_bf16(kf[1], Qf[0], negm, 0, 0, 0); \
            _Pragma("unroll") for (int s = 1; s < 3; ++s) { p0 = __builtin_amdgcn_mfma_f32_32x32x16_bf16(kf[2 * s], Qf[s], p0, 0, 0, 0); p1 = __builtin_amdgcn_mfma_f32_32x32x16_bf16(kf[2 * s + 1], Qf[s], p1, 0, 0, 0); } \
            __builtin_amdgcn_sched_barrier(0); \
            _Pragma("unroll") for (int s = 3; s < 6; ++s) { p0 = __builtin_amdgcn_mfma_f32_32x32x16_bf16(kg[2 * (s - 3)], Qf[s], p0, 0, 0, 0); p1 = __builtin_amdgcn_mfma_f32_32x32x16_bf16(kg[2 * (s - 3) + 1], Qf[s], p1, 0, 0, 0); } \
        } while (0)
#define AT_H2(T) do { const int t_ = (T); LAS unsigned char* Vs = lds + (t_ & 1) * AT_STAGE + AT_KB; \
            bf16x8 vf[4], vg[4]; \
            _Pragma("unroll") for (int s2 = 0; s2 < 2; ++s2) { vf[2 * s2] = *(const LAS bf16x8*)(Vs + qi * AT_VP + 32 * s2 + 16 * hi); vf[2 * s2 + 1] = *(const LAS bf16x8*)(Vs + (32 + qi) * AT_VP + 32 * s2 + 16 * hi); } \
            __builtin_amdgcn_sched_barrier(0); \
            float mxa = fmaxf(p0[0], p1[0]), mxb = fmaxf(p0[1], p1[1]), mxc = fmaxf(p0[2], p1[2]), mxd = fmaxf(p0[3], p1[3]); \
            _Pragma("unroll") for (int i = 4; i < 16; i += 4) { mxa = fmaxf(mxa, fmaxf(p0[i], p1[i])); mxb = fmaxf(mxb, fmaxf(p0[i + 1], p1[i + 1])); mxc = fmaxf(mxc, fmaxf(p0[i + 2], p1[i + 2])); mxd = fmaxf(mxd, fmaxf(p0[i + 3], p1[i + 3])); } \
            float mx = fmaxf(fmaxf(mxa, mxb), fmaxf(mxc, mxd)); \
            const bool resc = (t_ == 0) || (mx > 8.0f); \
            if (__builtin_amdgcn_ballot_w64(resc) != 0ull) { \
                mx = fmaxf(mx, __shfl_xor(mx, 32)); \
                const float d = (t_ == 0) ? mx : fmaxf(mx, 0.f); const float alpha = (t_ == 0) ? 1.0f : fast_exp2(-d); \
                lsum *= alpha; \
                _Pragma("unroll") for (int i = 0; i < 16; ++i) { o0[i] *= alpha; o1[i] *= alpha; p0[i] -= d; p1[i] -= d; negm[i] -= d; } \
            } \
            float rsa = 0.f, rsb = 0.f, rsc = 0.f, rsd = 0.f; \
            _Pragma("unroll") for (int i = 0; i < 16; i += 4) { \
                p0[i] = fast_exp2(p0[i]); p1[i] = fast_exp2(p1[i]); p0[i + 1] = fast_exp2(p0[i + 1]); p1[i + 1] = fast_exp2(p1[i + 1]); \
                p0[i + 2] = fast_exp2(p0[i + 2]); p1[i + 2] = fast_exp2(p1[i + 2]); p0[i + 3] = fast_exp2(p0[i + 3]); p1[i + 3] = fast_exp2(p1[i + 3]); \
                rsa += p0[i] + p1[i]; rsb += p0[i + 1] + p1[i + 1]; rsc += p0[i + 2] + p1[i + 2]; rsd += p0[i + 3] + p1[i + 3]; } \
            lsum += (rsa + rsb) + (rsc + rsd); \
            bf16x8 pf[2][2]; \
            _Pragma("unroll") for (int s2 = 0; s2 < 2; ++s2) { u32x4 a, b; \
                a.x = pg8::cvt_pk_bf16(p0[8 * s2 + 0], p0[8 * s2 + 1]); a.y = pg8::cvt_pk_bf16(p0[8 * s2 + 2], p0[8 * s2 + 3]); a.z = pg8::cvt_pk_bf16(p0[8 * s2 + 4], p0[8 * s2 + 5]); a.w = pg8::cvt_pk_bf16(p0[8 * s2 + 6], p0[8 * s2 + 7]); \
                b.x = pg8::cvt_pk_bf16(p1[8 * s2 + 0], p1[8 * s2 + 1]); b.y = pg8::cvt_pk_bf16(p1[8 * s2 + 2], p1[8 * s2 + 3]); b.z = pg8::cvt_pk_bf16(p1[8 * s2 + 4], p1[8 * s2 + 5]); b.w = pg8::cvt_pk_bf16(p1[8 * s2 + 6], p1[8 * s2 + 7]); \
                pf[0][s2] = __builtin_bit_cast(bf16x8, a); pf[1][s2] = __builtin_bit_cast(bf16x8, b); } \
            _Pragma("unroll") for (int s2 = 0; s2 < 2; ++s2) { vg[2 * s2] = *(const LAS bf16x8*)(Vs + qi * AT_VP + 64 + 32 * s2 + 16 * hi); vg[2 * s2 + 1] = *(const LAS bf16x8*)(Vs + (32 + qi) * AT_VP + 64 + 32 * s2 + 16 * hi); } \
            _Pragma("unroll") for (int s2 = 0; s2 < 2; ++s2) { o0 = __builtin_amdgcn_mfma_f32_32x32x16_bf16(vf[2 * s2], pf[0][s2], o0, 0, 0, 0); o1 = __builtin_amdgcn_mfma_f32_32x32x16_bf16(vf[2 * s2 + 1], pf[0][s2], o1, 0, 0, 0); } \
            __builtin_amdgcn_sched_barrier(0); \
            _Pragma("unroll") for (int s2 = 0; s2 < 2; ++s2) { o0 = __builtin_amdgcn_mfma_f32_32x32x16_bf16(vg[2 * s2], pf[1][s2], o0, 0, 0, 0); o1 = __builtin_amdgcn_mfma_f32_32x32x16_bf16(vg[2 * s2 + 1], pf[1][s2], o1, 0, 0, 0); } \
        } while (0)
#define AT_FEEDK(TN, RK, RR) do { const int tn_ = (TN); const unsigned tl_ = (unsigned)((tn_ + 2 < ntile) ? tn_ + 2 : ntile - 1); LAS unsigned char* Kn_ = lds + (tn_ & 1) * AT_STAGE; \
            *(LAS u32x4*)(Kn_ + lk_row * AT_KP + 16 * lk_c) = RK; \
            if (tid < 256) *(LAS u32x4*)(Kn_ + lr_row * AT_KP + 128 + 16 * lr_c) = RR; \
            gload16_async(RK, KN, kn_off + tl_ * 65536u); gload16_async(RR, KR, kr_off + tl_ * 4096u); \
            LDS_BARRIER(); } while (0)
#define AT_FEEDKB(TN, RK) do { const int tn_ = (TN); const unsigned tl_ = (unsigned)((tn_ + 2 < ntile) ? tn_ + 2 : ntile - 1); LAS unsigned char* Kn_ = lds + (tn_ & 1) * AT_STAGE; \
            *(LAS u32x4*)(Kn_ + lk_row * AT_KP + 16 * lk_c) = RK; \
            gload16_async(RK, KN, kn_off + tl_ * 65536u); \
            LDS_BARRIER(); } while (0)
#define AT_FEEDV(TN, RV) do { const int tn_ = (TN); const unsigned tl_ = (unsigned)((tn_ + 2 < ntile) ? tn_ + 2 : ntile - 1); LAS unsigned char* Kn_ = lds + (tn_ & 1) * AT_STAGE; \
            *(LAS u32x4*)(Kn_ + AT_KB + lv_row * AT_VP + 16 * lv_c) = RV; \
            gload16_async(RV, VT, vt_off + tl_ * 128u); \
            LDS_BARRIER(); } while (0)
        if (grp == 0) {
            for (int t = 0; t < ntile; t += 2) {
                AT_H1(t); AT_FEEDK(t + 1, rk, rr); AT_H2(t); AT_FEEDV(t + 1, rv);
                AT_H1(t + 1); AT_FEEDK(t + 2, rk2, rr2); AT_H2(t + 1); AT_FEEDV(t + 2, rv2);
            }
            AT_FEEDK(ntile + 1, rk, rr);
        } else {
            AT_FEEDKB(1, rk);
            for (int t = 0; t < ntile; t += 2) {
                AT_H1(t); AT_FEEDV(t + 1, rv); AT_H2(t); AT_FEEDKB(t + 2, rk2);
                AT_H1(t + 1); AT_FEEDV(t + 2, rv2); AT_H2(t + 1); AT_FEEDKB(t + 3, rk);
            }
        }
#undef AT_FEEDK
#undef AT_FEEDKB
#undef AT_FEEDV
#undef AT_H1
#undef AT_H2
        VM_WAIT_N(0);
        lsum += __shfl_xor(lsum, 32);
        const float inv = 1.0f / lsum;
        const unsigned op = 2u * (tokq * 512u + (unsigned)(64 * h + 4 * hi));
#pragma unroll
        for (int g4 = 0; g4 < 4; ++g4) {
            u32x2 a, b;
            a.x = pg8::cvt_pk_bf16(o0[4 * g4 + 0] * inv, o0[4 * g4 + 1] * inv); a.y = pg8::cvt_pk_bf16(o0[4 * g4 + 2] * inv, o0[4 * g4 + 3] * inv);
            b.x = pg8::cvt_pk_bf16(o1[4 * g4 + 0] * inv, o1[4 * g4 + 1] * inv); b.y = pg8::cvt_pk_bf16(o1[4 * g4 + 2] * inv, o1[4 * g4 + 3] * inv);
            *at<u32x2>(OUT, op + 16u * g4) = a; *at<u32x2>(OUT, op + 64u + 16u * g4) = b;
        }
    }
    __builtin_amdgcn_s_setprio(0);
    __syncthreads();
}

constexpr int RA_P = 288;
__device__ __forceinline__ void retA_phase(LAS unsigned char* lds, const bf16_t* RK, const bf16_t* RVT, bf16_t* ST, const float* ldf, const float* ldb, int slog, int nseq, int vcu, int G) {
    int tid_ = threadIdx.x; asm volatile("" : "+v"(tid_));
    const int tid = tid_, w = tid >> 6, lane = tid & 63, r16 = lane & 15, q = lane >> 4;
    const int S = 1 << slog, nch = S >> 7, nunits = nseq * 8 * nch;
    const int var = w >> 2, dvb = (w & 3) * 32;
    const int key = tid >> 2, d0 = (tid & 3) * 16;
#define RA_LOAD(UN) do { const int un_ = (UN); const int ch_ = un_ % nch, sh_ = un_ / nch, h_ = sh_ & 7, seq_ = sh_ >> 3; const size_t tokc_ = (size_t)seq_ * S + ch_ * 128; \
        pa = *(const u32x4*)(RK + (tokc_ + key) * 512 + 64 * h_ + d0); pb = *(const u32x4*)(RK + (tokc_ + key) * 512 + 64 * h_ + d0 + 8); \
        _Pragma("unroll") for (int b2 = 0; b2 < 2; ++b2) _Pragma("unroll") for (int ks = 0; ks < 4; ++ks) \
            pvf[b2][ks] = *(const bf16x8*)(RVT + ((size_t)(seq_ * 8 + h_) * 128 + dvb + 16 * b2 + r16) * S + ch_ * 128 + 32 * ks + 8 * q); } while (0)
    u32x4 pa, pb; bf16x8 pvf[2][4];
    if (vcu < nunits) RA_LOAD(vcu);
    for (int un = vcu; un < nunits; un += G) {
        const int ch = un % nch, sh = un / nch, h = sh & 7, seq = sh >> 3;
        const size_t tokc = (size_t)seq * S + ch * 128;
        const float lgf = ldf[h] * LOG2E, lgb = ldb[h] * LOG2E;
        bf16x8 vf[2][4];
        {
            const u32x4 a = pa, b = pb;
#pragma unroll
            for (int b2 = 0; b2 < 2; ++b2)
#pragma unroll
                for (int ks = 0; ks < 4; ++ks) vf[b2][ks] = pvf[b2][ks];
            const float sf = fast_exp2(lgf * (float)(127 - key)), sb = fast_exp2(lgb * (float)key);
            const int kp = (key & ~31) | (8 * ((key >> 2) & 3) + 4 * ((key >> 4) & 1) + (key & 3));
            const unsigned wv[8] = {a.x, a.y, a.z, a.w, b.x, b.y, b.z, b.w};
#pragma unroll
            for (int e = 0; e < 8; ++e) { const float x0 = bf_lo(wv[e]), x1 = bf_hi(wv[e]);
                *(LAS bf16_t*)(lds + (d0 + 2 * e) * RA_P + 2 * kp) = f2bf(x0 * sf); *(LAS bf16_t*)(lds + (d0 + 2 * e + 1) * RA_P + 2 * kp) = f2bf(x1 * sf);
                *(LAS bf16_t*)(lds + 64 * RA_P + (d0 + 2 * e) * RA_P + 2 * kp) = f2bf(x0 * sb); *(LAS bf16_t*)(lds + 64 * RA_P + (d0 + 2 * e + 1) * RA_P + 2 * kp) = f2bf(x1 * sb); }
        }
        __syncthreads();
        if (un + G < nunits) RA_LOAD(un + G);
        f32x4 acc[4][2];
#pragma unroll
        for (int db = 0; db < 4; ++db)
#pragma unroll
            for (int b2 = 0; b2 < 2; ++b2) acc[db][b2] = (f32x4){0.f, 0.f, 0.f, 0.f};
        const LAS unsigned char* Kx = lds + var * 64 * RA_P;
#pragma unroll
        for (int db = 0; db < 4; ++db)
#pragma unroll
            for (int ks = 0; ks < 4; ++ks) { const bf16x8 kf = *(const LAS bf16x8*)(Kx + (16 * db + r16) * RA_P + 64 * ks + 16 * q);
#pragma unroll
                for (int b2 = 0; b2 < 2; ++b2) acc[db][b2] = __builtin_amdgcn_mfma_f32_16x16x32_bf16(kf, vf[b2][ks], acc[db][b2], 0, 0, 0); }
        bf16_t* stp = ST + ((size_t)((tokc >> 7) * 8 + h) * 2 + var) * 8192;
#pragma unroll
        for (int db = 0; db < 4; ++db)
#pragma unroll
            for (int b2 = 0; b2 < 2; ++b2) { u32x2 wv2; wv2.x = pg8::cvt_pk_bf16(acc[db][b2][0], acc[db][b2][1]); wv2.y = pg8::cvt_pk_bf16(acc[db][b2][2], acc[db][b2][3]);
                *(u32x2*)(stp + (dvb + 16 * b2 + r16) * 64 + 16 * db + 4 * q) = wv2; }
        __syncthreads();
    }
#undef RA_LOAD
}
__device__ __forceinline__ void retB_phase(bf16_t* ST, const float* ldf, const float* ldb, int slog, int nseq, long gtid, long gthreads) {
    const int S = 1 << slog, nch = S >> 7; const long items = (long)nseq * 8 * 2 * 1024;
    for (long it = gtid; it < items; it += gthreads) {
        const int vec = (int)(it & 1023), var = (int)((it >> 10) & 1), h = (int)((it >> 11) & 7), seq = (int)(it >> 14);
        const float gam = fast_exp2((var ? ldb[h] : ldf[h]) * LOG2E * 128.0f);
        float run[8];
#pragma unroll
        for (int e = 0; e < 8; ++e) run[e] = 0.f;
        for (int n0 = 0; n0 < nch; n0 += 16) {
            u32x4 v[16]; bf16_t* p[16];
#pragma unroll
            for (int j = 0; j < 16; ++j) { const int n = var ? (nch - 1 - (n0 + j)) : (n0 + j); p[j] = ST + ((size_t)((seq * nch + n) * 8 + h) * 2 + var) * 8192 + vec * 8; v[j] = *(const u32x4*)p[j]; }
#pragma unroll
            for (int j = 0; j < 16; ++j) {
                u32x4 o; o.x = pg8::cvt_pk_bf16(run[0], run[1]); o.y = pg8::cvt_pk_bf16(run[2], run[3]); o.z = pg8::cvt_pk_bf16(run[4], run[5]); o.w = pg8::cvt_pk_bf16(run[6], run[7]);
                *(u32x4*)p[j] = o;
                run[0] = run[0] * gam + bf_lo(v[j].x); run[1] = run[1] * gam + bf_hi(v[j].x); run[2] = run[2] * gam + bf_lo(v[j].y); run[3] = run[3] * gam + bf_hi(v[j].y);
                run[4] = run[4] * gam + bf_lo(v[j].z); run[5] = run[5] * gam + bf_hi(v[j].z); run[6] = run[6] * gam + bf_lo(v[j].w); run[7] = run[7] * gam + bf_hi(v[j].w);
            }
        }
    }
}
constexpr int RC_KP = 160, RC_VP = 288, RC_SP = 160;
constexpr int RC_K = 0, RC_V = 128 * RC_KP, RC_SF = RC_V + 128 * RC_VP, RC_SB = RC_SF + 128 * RC_SP;
__device__ __forceinline__ void retC_phase(LAS unsigned char* lds, const bf16_t* RQ, const bf16_t* RK, const bf16_t* RVT, const bf16_t* ST, const bf16_t* SRG, bf16_t* OB,
                                           const float* ldf, const float* ldb, int slog, int nseq, int vcu, int G) {
    int tid_ = threadIdx.x; asm volatile("" : "+v"(tid_));
    const int tid = tid_, w = tid >> 6, lane = tid & 63, r16 = lane & 15, q = lane >> 4;
    const int S = 1 << slog, nch = S >> 7, nunits = nseq * 8 * nch;
#define RC_LOAD(UN) do { const int un_ = (UN); const int ch_ = un_ % nch, sh_ = un_ / nch, h_ = sh_ & 7, seq_ = sh_ >> 3; const size_t tokc_ = (size_t)seq_ * S + ch_ * 128; \
        _Pragma("unroll") for (int i = 0; i < 2; ++i) { const int id = tid + 512 * i, row = id >> 3, c = id & 7; pk[i] = *(const u32x4*)(RK + (tokc_ + row) * 512 + 64 * h_ + 8 * c); } \
        _Pragma("unroll") for (int i = 0; i < 4; ++i) { const int id = tid + 512 * i, row = id >> 4, c = id & 15; pv[i] = *(const u32x4*)(RVT + ((size_t)(seq_ * 8 + h_) * 128 + row) * S + ch_ * 128 + 8 * c); } \
        const bf16_t* stf_ = ST + ((size_t)((tokc_ >> 7) * 8 + h_) * 2) * 8192; \
        _Pragma("unroll") for (int i = 0; i < 2; ++i) { const int id = tid + 512 * i, row = id >> 3, c = id & 7; psf[i] = *(const u32x4*)(stf_ + row * 64 + 8 * c); psb[i] = *(const u32x4*)(stf_ + 8192 + row * 64 + 8 * c); } \
        _Pragma("unroll") for (int s_ = 0; s_ < 2; ++s_) pq[s_] = *(const bf16x8*)(RQ + (tokc_ + 16 * w + r16) * 512 + 64 * h_ + 32 * s_ + 8 * q); } while (0)
    u32x4 pk[2], pv[4], psf[2], psb[2]; bf16x8 pq[2];
    if (vcu < nunits) RC_LOAD(vcu);
    for (int un = vcu; un < nunits; un += G) {
        const int ch = un % nch, sh = un / nch, h = sh & 7, seq = sh >> 3;
        const size_t tokc = (size_t)seq * S + ch * 128;
        const float lgf = ldf[h] * LOG2E, lgb = ldb[h] * LOG2E;
#pragma unroll
        for (int i = 0; i < 2; ++i) { const int id = tid + 512 * i, row = id >> 3, c = id & 7; *(LAS u32x4*)(lds + RC_K + row * RC_KP + 16 * c) = pk[i]; }
#pragma unroll
        for (int i = 0; i < 4; ++i) { const int id = tid + 512 * i, row = id >> 4, c = id & 15; *(LAS u32x4*)(lds + RC_V + row * RC_VP + 16 * c) = pv[i]; }
#pragma unroll
        for (int i = 0; i < 2; ++i) { const int id = tid + 512 * i, row = id >> 3, c = id & 7;
            *(LAS u32x4*)(lds + RC_SF + row * RC_SP + 16 * c) = psf[i]; *(LAS u32x4*)(lds + RC_SB + row * RC_SP + 16 * c) = psb[i]; }
        bf16x8 Qf[2];
#pragma unroll
        for (int s = 0; s < 2; ++s) Qf[s] = pq[s];
        __syncthreads();
        u32x2 gqv[8];
#pragma unroll
        for (int dvb = 0; dvb < 8; ++dvb) gqv[dvb] = *(const u32x2*)(SRG + (tokc + 16 * w + r16) * 1024 + 128 * h + 16 * dvb + 4 * q);
        if (un + G < nunits) RC_LOAD(un + G);
        const int iq = 16 * w + r16; const size_t tok = tokc + iq;
        bf16x8 pf[4];
#pragma unroll
        for (int ks = 0; ks < 4; ++ks) {
            f32x4 sa[2];
#pragma unroll
            for (int hb = 0; hb < 2; ++hb) { const int kb = 2 * ks + hb; sa[hb] = (f32x4){0.f, 0.f, 0.f, 0.f};
#pragma unroll
                for (int s = 0; s < 2; ++s) { const bf16x8 kf = *(const LAS bf16x8*)(lds + RC_K + (16 * kb + r16) * RC_KP + 64 * s + 16 * q);
                    sa[hb] = __builtin_amdgcn_mfma_f32_16x16x32_bf16(kf, Qf[s], sa[hb], 0, 0, 0); }
#pragma unroll
                for (int i = 0; i < 4; ++i) { const int j = 16 * kb + 4 * q + i; const int df = iq - j; const float arg = (df >= 0) ? lgf * (float)df : lgb * (float)(-df); sa[hb][i] *= fast_exp2(arg); } }
            u32x4 pk; pk.x = pg8::cvt_pk_bf16(sa[0][0], sa[0][1]); pk.y = pg8::cvt_pk_bf16(sa[0][2], sa[0][3]); pk.z = pg8::cvt_pk_bf16(sa[1][0], sa[1][1]); pk.w = pg8::cvt_pk_bf16(sa[1][2], sa[1][3]);
            pf[ks] = __builtin_bit_cast(bf16x8, pk);
        }
        bf16x8 Qff[2], Qfb[2];
        { const float cf = fast_exp2(lgf * (float)(iq + 1)), cb = fast_exp2(lgb * (float)(128 - iq));
#pragma unroll
          for (int s = 0; s < 2; ++s) { const u32x4 qv = __builtin_bit_cast(u32x4, Qf[s]); const unsigned wv[4] = {qv.x, qv.y, qv.z, qv.w}; u32x4 a, b; unsigned ra[4], rb[4];
#pragma unroll
              for (int e = 0; e < 4; ++e) { const float x0 = bf_lo(wv[e]), x1 = bf_hi(wv[e]); ra[e] = pg8::cvt_pk_bf16(x0 * cf, x1 * cf); rb[e] = pg8::cvt_pk_bf16(x0 * cb, x1 * cb); }
              a.x = ra[0]; a.y = ra[1]; a.z = ra[2]; a.w = ra[3]; b.x = rb[0]; b.y = rb[1]; b.z = rb[2]; b.w = rb[3];
              Qff[s] = __builtin_bit_cast(bf16x8, a); Qfb[s] = __builtin_bit_cast(bf16x8, b); } }
        f32x4 oacc[8]; float ss = 0.f;
#pragma unroll
        for (int dvb = 0; dvb < 8; ++dvb) { f32x4 o = (f32x4){0.f, 0.f, 0.f, 0.f};
#pragma unroll
            for (int ks = 0; ks < 4; ++ks) { const bf16x8 vfr = *(const LAS bf16x8*)(lds + RC_V + (16 * dvb + r16) * RC_VP + 64 * ks + 16 * q);
                o = __builtin_amdgcn_mfma_f32_16x16x32_bf16(vfr, pf[ks], o, 0, 0, 0); }
#pragma unroll
            for (int s = 0; s < 2; ++s) { const bf16x8 sf = *(const LAS bf16x8*)(lds + RC_SF + (16 * dvb + r16) * RC_SP + 64 * s + 16 * q);
                const bf16x8 sb = *(const LAS bf16x8*)(lds + RC_SB + (16 * dvb + r16) * RC_SP + 64 * s + 16 * q);
                o = __builtin_amdgcn_mfma_f32_16x16x32_bf16(sf, Qff[s], o, 0, 0, 0);
                o = __builtin_amdgcn_mfma_f32_16x16x32_bf16(sb, Qfb[s], o, 0, 0, 0); }
            oacc[dvb] = o; ss += (o[0] * o[0] + o[1] * o[1]) + (o[2] * o[2] + o[3] * o[3]); }
        ss += __shfl_xor(ss, 16); ss += __shfl_xor(ss, 32);
        const float rstd = rsqrtf(ss * (1.0f / 128.0f) + EPS);
#pragma unroll
        for (int dvb = 0; dvb < 8; ++dvb) { const size_t off = tok * 1024 + 128 * h + 16 * dvb + 4 * q; const u32x2 gq = gqv[dvb];
            const f32x4 o = oacc[dvb]; u32x2 wv2; wv2.x = pg8::cvt_pk_bf16(o[0] * rstd * bf_lo(gq.x), o[1] * rstd * bf_hi(gq.x)); wv2.y = pg8::cvt_pk_bf16(o[2] * rstd * bf_lo(gq.y), o[3] * rstd * bf_hi(gq.y));
            *(u32x2*)(OB + off) = wv2; }
        __syncthreads();
    }
#undef RC_LOAD
}

#define XB_TMO      128
#define XB_XCNT(j)  (256  + 64 * (j))
#define XB_XSUB(j)  (1280 + 64 * (j))
#define XB_XGEN(j)  (2304 + 64 * (j))
#define XB_TOP      3328
#define XB_TOPGEN   3392
#define XCD_BAR_WORDS 3456
#define XB_SPIN_CAP (1u << 18)
__device__ __forceinline__ unsigned xb_ld(unsigned* p)              { return __hip_atomic_load(p, __ATOMIC_RELAXED, __HIP_MEMORY_SCOPE_AGENT); }
__device__ __forceinline__ unsigned xb_add(unsigned* p, unsigned v) { return __hip_atomic_fetch_add(p, v, __ATOMIC_RELAXED, __HIP_MEMORY_SCOPE_AGENT); }
__device__ __forceinline__ unsigned xb_xcc_id() { return (unsigned)__builtin_amdgcn_s_getreg((3 << 11) | 20) & 0xFu; }
#define XB_SPIN(cond, bar) do { unsigned _sp = 0; while (cond) { __builtin_amdgcn_s_sleep(1); \
    if ((++_sp & 255u) == 0u) { if (xb_ld(&(bar)[XB_TMO])) break; if (_sp > XB_SPIN_CAP) { atomicAdd(&(bar)[XB_TMO], 1u); break; } } } } while (0)
struct XcdBarrier { unsigned* bar; unsigned x; volatile LAS unsigned* st; };
__device__ __forceinline__ XcdBarrier xcd_barrier_post(unsigned* bar, volatile LAS unsigned* st) {
    XcdBarrier b; b.bar = bar; b.x = xb_xcc_id(); b.st = st;
    if (threadIdx.x == 0) (void)xb_add(&bar[XB_XCNT(b.x)], 1u);
    return b;
}
__device__ __forceinline__ void xcd_barrier_complete(unsigned* bar, unsigned x, unsigned& nloc, unsigned& nx) {
    const unsigned G = gridDim.x * gridDim.y * gridDim.z;
    unsigned sum, cnt, mine, sp = 0u;
    for (;;) {
        sum = 0u; cnt = 0u; mine = 0u;
#pragma unroll
        for (unsigned j = 0; j < 16; ++j) { const unsigned c = xb_ld(&bar[XB_XCNT(j)]); sum += c; cnt += (c > 0u) ? 1u : 0u; mine = (j == x) ? c : mine; }
        if (sum == G) break;
        __builtin_amdgcn_s_sleep(1);
        if ((++sp & 255u) == 0u) { if (xb_ld(&bar[XB_TMO])) break; if (sp > XB_SPIN_CAP) { atomicAdd(&bar[XB_TMO], 1u); break; } }
    }
    nloc = mine > 0u ? mine : 1u; nx = cnt > 0u ? cnt : 1u;
}
__device__ __forceinline__ void xcd_barrier(const XcdBarrier& b) {
    asm volatile("s_waitcnt vmcnt(0)" ::: "memory");
    __syncthreads();
    if (threadIdx.x == 0) {
        unsigned* bar = b.bar; asm volatile("" : "+s"(bar));
        __builtin_amdgcn_s_waitcnt(0);
        unsigned nloc = b.st[0], nx = b.st[1];
        if (nloc == 0u) { xcd_barrier_complete(bar, b.x, nloc, nx); b.st[0] = nloc; b.st[1] = nx; }
        const unsigned old = xb_add(&bar[XB_XSUB(b.x)], 1u);
        const unsigned gen = old / nloc;
        if (old + 1u == (gen + 1u) * nloc) {
            __builtin_amdgcn_fence(__ATOMIC_RELEASE, "agent");
            asm volatile("s_waitcnt vmcnt(0)" ::: "memory");
            const unsigned og = xb_add(&bar[XB_TOP], 1u);
            const unsigned tg = og / nx;
            if (og + 1u == (tg + 1u) * nx) xb_add(&bar[XB_TOPGEN], 1u);
            else XB_SPIN(xb_ld(&bar[XB_TOPGEN]) == tg, bar);
            __builtin_amdgcn_fence(__ATOMIC_ACQUIRE, "agent");
            xb_add(&bar[XB_XGEN(b.x)], 1u);
            asm volatile("s_waitcnt vmcnt(0)" ::: "memory");
        } else {
            XB_SPIN(xb_ld(&bar[XB_XGEN(b.x)]) == gen, bar);
            __builtin_amdgcn_fence(__ATOMIC_ACQUIRE, "agent");
            asm volatile("s_waitcnt vmcnt(0)" ::: "memory");
        }
    }
    __syncthreads();
}

#define WSP(off) (ws + (off))
#define SSQ ((float*)WSP(WS_SSQ))
#define W1A ((bf16_t*)WSP(WS_W1A))
#define W1B ((bf16_t*)WSP(WS_W1B))
#define WQ ((bf16_t*)WSP(WS_WQ))
#define WKV ((bf16_t*)WSP(WS_WKV))
#define WA ((bf16_t*)WSP(WS_WA))
#define WB ((bf16_t*)WSP(WS_WB))
#define WO ((bf16_t*)WSP(WS_WO))
#define WU ((bf16_t*)WSP(WS_WU))
#define WD ((bf16_t*)WSP(WS_WD))
#define HBF ((bf16_t*)WSP(A_HBF))
#define CQ ((bf16_t*)WSP(A_CQ))
#define CKV ((bf16_t*)WSP(A_CKV))
#define KR ((bf16_t*)WSP(A_KR))
#define RQ ((bf16_t*)WSP(A_RQ))
#define RK ((bf16_t*)WSP(A_RK))
#define RVT ((bf16_t*)WSP(A_RVT))
#define QN ((bf16_t*)WSP(A_QN))
#define QR ((bf16_t*)WSP(A_QR))
#define KN ((bf16_t*)WSP(A_KN))
#define VT ((bf16_t*)WSP(A_VT))
#define ST ((bf16_t*)WSP(A_ST))
#define G3 ((bf16_t*)WSP(A_G3))
#define SRG G3
#define SGA (G3 + (size_t)TG * 1024)
#define SGB (G3 + (size_t)2 * TG * 1024)
#define OB ((bf16_t*)WSP(A_OB))
#define MA ((bf16_t*)WSP(A_MA))
#define MG ((bf16_t*)WSP(A_MG))
#define MF ((bf16_t*)WSP(A_MF))
#define H2 ((bf16_t*)WSP(A_H2))
#define U ((bf16_t*)WSP(A_U))
#define DF ((bf16_t*)WSP(A_DF))
#define X1 ((bf16_t*)WSP(A_X1))
#define SSQP(g, k) (SSQ + (size_t)((g) * 4 + (k)) * TG)
#ifndef PHSEL
#define PHSEL -1
#endif
#define SEL(n) if constexpr (PHSEL < 0 || PHSEL == (n))
#define PHASE_BEGIN ArgsP ap = ap0; asm volatile("" : "+s"(ap)); unsigned char* ws = ap->ws; int tidp = threadIdx.x; asm volatile("" : "+v"(tidp)); \
    const int lane = tidp & 63, wave = tidp >> 6; const int vcu = (G % 8 == 0) ? (bx % 8) * (G / 8) + bx / 8 : bx; const long gtid = (long)bx * 512 + tidp, gthreads = (long)G * 512; const int gw = bx * 8 + wave, ngw = G * 8; \
    const float* xg = (g < 2) ? ap->x_prompt + (size_t)g * TG * DM : ap->x_sample; float* outg = ap->out + (size_t)g * TG * DM; \
    (void)lane; (void)vcu; (void)gtid; (void)gthreads; (void)gw; (void)ngw; (void)xg; (void)outg; (void)ws;

__global__ void __launch_bounds__(512, 2) fwd_megakernel(Args a_unused) {
    extern __shared__ __attribute__((aligned(16))) unsigned char lds_raw[];
    LAS unsigned char* lds = (LAS unsigned char*)lds_raw;
    cg::grid_group grid = cg::this_grid();
    typedef const __attribute__((address_space(4))) Args* ArgsP;
    ArgsP ap0 = (ArgsP)__builtin_amdgcn_kernarg_segment_ptr();
    const int G = gridDim.x, bx = blockIdx.x;
    volatile LAS unsigned* bst = (volatile LAS unsigned*)(lds + 131072 + 64);
    if (threadIdx.x < 2) bst[threadIdx.x] = 0u;
    __syncthreads();
    XcdBarrier xbar = xcd_barrier_post((unsigned*)(ap0->ws + WS_BAR), bst);
#define GSYNC() xcd_barrier(xbar)
    for (int g = 0; g < NGROUPS; ++g) {
        const int slog = (g < 2) ? 11 : 13, nseq = (g < 2) ? 16 : 4;

        if (g == 0) {
        { PHASE_BEGIN
            for (long i = gtid; i < (long)NGROUPS * 4 * TG; i += gthreads) SSQ[i] = 0.f;
            {
                constexpr int I0 = N1A * 16, I1 = N1B * 16, I2 = NQ * 4, I3 = NKV * 2, I4 = 1024 * 8, I5 = 1024 * 16, I6 = 1024 * 16, I7 = 4096 * 16, I8 = 1024 * 64;
                constexpr int ITOT = I0 + I1 + I2 + I3 + I4 + I5 + I6 + I7 + I8;
                for (int it = (int)gtid; it < ITOT; it += (int)gthreads) {
                    int r = it; CW c;
                    if (r < I0) c = CW{ap->w_in, 5536, 1024, N1A, 1, 0, nullptr, W1A};
                    else if ((r -= I0) < I1) c = CW{ap->w_in, 5536, 1024, N1B, 0, 2464, nullptr, W1B};
                    else if ((r -= I1) < I2) c = CW{ap->w_q_up, 768, 256, NQ, 2, 0, ap->g_q_norm, WQ};
                    else if ((r -= I2) < I3) c = CW{ap->w_kv_up, 1024, 128, NKV, 3, 0, ap->g_kv_norm, WKV};
                    else if ((r -= I3) < I4) c = CW{ap->w_branch_a, 1024, 512, 1024, 0, 0, nullptr, WA};
                    else if ((r -= I4) < I5) c = CW{ap->w_branch_b, 1024, 1024, 1024, 0, 0, nullptr, WB};
                    else if ((r -= I5) < I6) c = CW{ap->w_out, 1024, 1024, 1024, 0, 0, nullptr, WO};
                    else if ((r -= I6) < I7) c = CW{ap->w_up, 4096, 1024, 4096, 0, 0, ap->g_pre_mlp, WU};
                    else { r -= I7; c = CW{ap->w_down, 1024, 4096, 1024, 0, 0, nullptr, WD}; }
                    convert_item(c, r);
                }
            }
            rowpass0(xg, ap->g_pre_mix, HBF, gw, ngw, lane);
        }
        if (G == 0x7fffffff) grid.sync(); else GSYNC();
        }
        { PHASE_BEGIN
        SEL(1) { pg8::Gemm gm{HBF, W1A, TG, N1A, 1024}; pg8::StaticOrder S; S.init(TG, N1A, G, bx);
          Epi1 E{CQ, CKV, KR, RQ, RK, RVT, SSQP(g, 0), SSQP(g, 1), slog, lds + LDS_TSCR};
          pg8::gemm_phase<Epi1, pg8::StaticOrder, true, true>(lds, gm, S, E); }
        }
        GSYNC();
        { PHASE_BEGIN
        SEL(20) { pg8::Gemm gm{CQ, WQ, TG, NQ, 256}; pg8::StaticOrder S; S.init(TG, NQ, G, bx);
          Epi2q E{QN, QR, SSQP(g, 0), slog};
          pg8::gemm_phase<Epi2q, pg8::StaticOrder, true, true>(lds, gm, S, E); }
        SEL(21) { pg8::Gemm gm{CKV, WKV, TG, NKV, 128}; pg8::StaticOrder S; S.init(TG, NKV, G, bx);
          Epi2kv E{KN, VT, SSQP(g, 1), slog, lds + LDS_TSCR};
          pg8::gemm_phase<Epi2kv, pg8::StaticOrder, true, true>(lds, gm, S, E); }
        SEL(22) retA_phase(lds, RK, RVT, ST, ap->ldf, ap->ldb, slog, nseq, vcu, G);
#ifdef PROBE_RET2
        retA_phase(lds, RK, RVT, ST, ap->ldf, ap->ldb, slog, nseq, vcu, G);
#endif
        }
        GSYNC();
        { PHASE_BEGIN
        SEL(30) retB_phase(ST, ap->ldf, ap->ldb, slog, nseq, gtid, gthreads);
#ifdef PROBE_ATTN2
        attn_phase(lds, QN, OB, QR, KN, KR, VT, slog, nseq, vcu, G);
#endif
        SEL(31) attn_phase(lds, QN, QN, QR, KN, KR, VT, slog, nseq, vcu, G);
        SEL(32) { pg8::Gemm gm{HBF, W1B, TG, N1B, 1024}; pg8::StaticOrder S; S.init(TG, N1B, G, bx);
          EpiAct<1> E{G3, 1024, nullptr};
          pg8::gemm_phase<EpiAct<1>, pg8::StaticOrder, true, true>(lds, gm, S, E); }
        }
        GSYNC();
        { PHASE_BEGIN
        SEL(40) retC_phase(lds, RQ, RK, RVT, ST, SRG, OB, ap->ldf, ap->ldb, slog, nseq, vcu, G);
#ifdef PROBE_RET2
        retC_phase(lds, RQ, RK, RVT, ST, SRG, OB, ap->ldf, ap->ldb, slog, nseq, vcu, G);
#endif
        SEL(41) { pg8::Gemm gm{QN, WA, TG, 1024, 512}; pg8::StaticOrder S; S.init(TG, 1024, G, bx);
          Epi4 E{SGA, MA};
          pg8::gemm_phase<Epi4, pg8::StaticOrder, true, true>(lds, gm, S, E); }
        }
        GSYNC();
        { PHASE_BEGIN
        SEL(5) { pg8::Gemm gm{OB, WB, TG, 1024, 1024}; pg8::StaticOrder S; S.init(TG, 1024, G, bx);
          Epi5 E{SGB, MA, MG};
          pg8::gemm_phase<Epi5, pg8::StaticOrder, true, true>(lds, gm, S, E); }
        }
        GSYNC();
        { PHASE_BEGIN
        SEL(6) { pg8::Gemm gm{MG, WO, TG, 1024, 1024}; pg8::StaticOrder S; S.init(TG, 1024, G, bx);
          EpiF32Ssq E{MF, SSQP(g, 2)};
          pg8::gemm_phase<EpiF32Ssq, pg8::StaticOrder, true, true>(lds, gm, S, E); }
        }
        GSYNC();
        { PHASE_BEGIN
        SEL(7) rowpass1(xg, MF, SSQP(g, 2), ap->g_post_mix, X1, SSQP(g, 0), gw, ngw, lane);
        }
        GSYNC();
        { PHASE_BEGIN
        SEL(8) { pg8::Gemm gm{X1, WU, TG, DFF, 1024}; pg8::StaticOrder S; S.init(TG, DFF, G, bx);
          EpiAct<2> E{U, DFF, SSQP(g, 0)};
          pg8::gemm_phase<EpiAct<2>, pg8::StaticOrder, true, true>(lds, gm, S, E);
#ifdef PROBE_UP2
          pg8::gemm_phase<EpiAct<2>, pg8::StaticOrder, true, true>(lds, gm, S, E);
#endif
        }
        }
        GSYNC();
        { PHASE_BEGIN
        SEL(9) { pg8::Gemm gm{U, WD, TG, 1024, DFF}; pg8::StaticOrder S; S.init(TG, 1024, G, bx, 1);
          EpiF32Ssq E{DF, SSQP(g, 3)};
          pg8::gemm_phase<EpiF32Ssq, pg8::StaticOrder, true, true>(lds, gm, S, E); }
        }
        GSYNC();
        { PHASE_BEGIN
        SEL(10) rowpass2(X1, DF, SSQP(g, 3), ap->g_post_mlp, outg, gw, ngw, lane);
        if (g + 1 < NGROUPS) { const float* xn = (g + 1 < 2) ? ap->x_prompt + (size_t)(g + 1) * TG * DM : ap->x_sample; rowpass0(xn, ap->g_pre_mix, HBF, gw, ngw, lane); }
        }
        if (g + 1 < NGROUPS) GSYNC();
#ifdef PROBE_SYNC
        for (int i_ = 0; i_ < 10; ++i_) GSYNC();
#endif
    }
}

extern "C" void kernel_launch(void* const* d_in, const int* in_sizes, int n_in, void* d_out, int out_size, void* d_ws, size_t ws_size, hipStream_t stream) {
    static int grid = 0;
    if (grid == 0) {
        if (n_in != 18 || ws_size < WS_NEED) { fprintf(stderr, "kernel_launch: unexpected n_in %d / ws %zu (need %zu)\n", n_in, ws_size, (size_t)WS_NEED); grid = -1; return; }
        int dev = 0, cus = 0, per_cu = 0;
        (void)hipGetDevice(&dev); (void)hipDeviceGetAttribute(&cus, hipDeviceAttributeMultiprocessorCount, dev);
        if (hipFuncSetAttribute((const void*)fwd_megakernel, hipFuncAttributeMaxDynamicSharedMemorySize, LDS_BYTES) != hipSuccess) { fprintf(stderr, "hipFuncSetAttribute failed\n"); grid = -1; return; }
        if (hipOccupancyMaxActiveBlocksPerMultiprocessor(&per_cu, (const void*)fwd_megakernel, 512, LDS_BYTES) != hipSuccess || per_cu < 1) { fprintf(stderr, "occupancy query: %d\n", per_cu); per_cu = 1; }
        (void)hipGetLastError();
        grid = cus;
    }
    if (grid < 0) return;
    Args a{};
    a.x_prompt = (const float*)d_in[0]; a.x_sample = (const float*)d_in[1]; a.g_pre_mix = (const float*)d_in[2]; a.w_in = (const float*)d_in[3];
    a.g_q_norm = (const float*)d_in[4]; a.w_q_up = (const float*)d_in[5]; a.g_kv_norm = (const float*)d_in[6]; a.w_kv_up = (const float*)d_in[7];
    a.w_branch_a = (const float*)d_in[8]; a.ldf = (const float*)d_in[9]; a.ldb = (const float*)d_in[10]; a.w_branch_b = (const float*)d_in[11];
    a.w_out = (const float*)d_in[12]; a.g_post_mix = (const float*)d_in[13]; a.g_pre_mlp = (const float*)d_in[14]; a.w_up = (const float*)d_in[15];
    a.w_down = (const float*)d_in[16]; a.g_post_mlp = (const float*)d_in[17];
    a.out = (float*)d_out; a.ws = (unsigned char*)d_ws;
    if (hipMemsetAsync((char*)d_ws + WS_BAR, 0, 16384, stream) != hipSuccess) { fprintf(stderr, "memset failed\n"); return; }
    void* args[] = {&a};
    hipError_t e = hipLaunchCooperativeKernel((const void*)fwd_megakernel, dim3(grid), dim3(512), args, LDS_BYTES, stream);
    if (e != hipSuccess) fprintf(stderr, "cooperative launch failed: %s (grid %d)\n", hipGetErrorString(e), grid);
}
```
